# Optimizing an MI355X kernel written in HIP

```python
import math
import jax
import jax.numpy as jnp
from jax import lax
import numpy as np

D_MODEL = 2048
BATCH = 2
SEQ = 4096
DEPTH = 2

GRID_W = 64
CTX_LEN = 256
N_BRANCH = 3
DA_HEADS = 8
DA_HEAD_DIM = 64
DA_V_DIM = 2 * DA_HEAD_DIM
DA_WIDTH = DA_HEADS * DA_V_DIM
Q_BLOCK = 128
ROPE_THETA = 10000.0
SSD_HEADS = 16
SSD_HEAD_DIM = 64
SSD_GROUPS = 2
SSD_HPG = SSD_HEADS // SSD_GROUPS
SSD_STATE = 128
SSD_WIDTH = SSD_HEADS * SSD_HEAD_DIM
SSD_XBC = SSD_WIDTH + 2 * SSD_GROUPS * SSD_STATE
SSD_CONV = 5
SSD_CHUNK = 128
S5_GROUP = 16
S5_GROUPS = 64
S5_WIDTH = S5_GROUPS * S5_GROUP
S5_STATE = 64
D_FF = int(math.ceil(8 * D_MODEL / 3 / 256)) * 256
Q_OFF = 0
K_OFF = Q_OFF + DA_WIDTH
V_OFF = K_OFF + DA_WIDTH
Z_OFF = V_OFF + DA_WIDTH
XBC_OFF = Z_OFF + SSD_WIDTH
DT_OFF = XBC_OFF + SSD_XBC
U_OFF = DT_OFF + 2 * SSD_HEADS
GATE_OFF = U_OFF + S5_WIDTH
N_IN = GATE_OFF + N_BRANCH * D_MODEL
RMS_EPS = 1e-6

kernel_name = 'hybrid_diffattn_ssd_s5_block'


def rms_norm(x, g):
    xf = x.astype(jnp.float32)
    y = xf * lax.rsqrt(jnp.mean(xf * xf, axis=-1, keepdims=True) + RMS_EPS)
    return (y * g.astype(jnp.float32)).astype(x.dtype)


def modulate(h, shift, scale):
    return h * (1 + scale) + shift


def swiglu(h, w_gate, w_up, w_down):
    return (jax.nn.silu(h @ w_gate) * (h @ w_up)) @ w_down


def flip_seq(t):
    return jnp.flip(t, axis=1)


def axial_rope_tables(n_tokens):
    n_rows = n_tokens // GRID_W
    row = jnp.repeat(jnp.arange(n_rows, dtype=jnp.float32), GRID_W)
    col = jnp.tile(jnp.arange(GRID_W, dtype=jnp.float32), n_rows)
    half = DA_HEAD_DIM // 2
    inv_freq = ROPE_THETA ** (-jnp.arange(0, half, 2, dtype=jnp.float32) / half)

    def axis_angles(pos):
        a = pos[:, None] * inv_freq[None, :]
        return jnp.concatenate([a, a], axis=-1)

    ang = jnp.concatenate([axis_angles(row), axis_angles(col)], axis=-1)
    return jnp.cos(ang), jnp.sin(ang)


def rotate_half(x):
    x1, x2 = jnp.split(x, 2, axis=-1)
    return jnp.concatenate([-x2, x1], axis=-1)


def apply_axial_rope(x, cos, sin):
    half = DA_HEAD_DIM // 2
    rot = jnp.concatenate([rotate_half(x[..., :half]), rotate_half(x[..., half:])], axis=-1)
    c = cos[None, :, None, None, :]
    s = sin[None, :, None, None, :]
    return (x.astype(jnp.float32) * c + rot.astype(jnp.float32) * s).astype(x.dtype)


def diff_attn_block(q, k, v, lam):
    s = jnp.einsum('bqhcd,bkhcd->bhcqk', q, k).astype(jnp.float32) * (DA_HEAD_DIM ** -0.5)
    p = jax.nn.softmax(s, axis=-1)
    a = p[:, :, 0] - lam * p[:, :, 1]
    return jnp.einsum('bhqk,bkhe->bqhe', a.astype(v.dtype), v)


def diff_attention_sweep(q, k, v, lam):
    b, n_q = q.shape[:2]
    n_blk = n_q // Q_BLOCK
    qb = jnp.moveaxis(q.reshape(b, n_blk, Q_BLOCK, DA_HEADS, 2, DA_HEAD_DIM), 1, 0)
    ob = lax.map(lambda qq: diff_attn_block(qq, k, v, lam), qb)
    return jnp.moveaxis(ob, 0, 1).reshape(b, n_q, DA_HEADS, DA_V_DIM)


def depthwise_conv_centred(x, w, b):
    pad = SSD_CONV // 2
    y = lax.conv_general_dilated(x, w[:, None, :], window_strides=(1,), padding=[(pad, pad)],
                                 dimension_numbers=('NWC', 'WIO', 'NWC'),
                                 feature_group_count=x.shape[-1])
    return y + b


def ssd_inputs(xbc_raw, dt_raw, conv_w, conv_b, dt_bias):
    b, n = xbc_raw.shape[:2]
    xbc = jax.nn.silu(depthwise_conv_centred(xbc_raw, conv_w, conv_b)).astype(jnp.float32)
    gn = SSD_GROUPS * SSD_STATE
    xs = xbc[..., :SSD_WIDTH].reshape(b, n, SSD_GROUPS, SSD_HPG, SSD_HEAD_DIM)
    bm = xbc[..., SSD_WIDTH:SSD_WIDTH + gn].reshape(b, n, SSD_GROUPS, SSD_STATE)
    cm = xbc[..., SSD_WIDTH + gn:].reshape(b, n, SSD_GROUPS, SSD_STATE)
    dt = jax.nn.softplus(dt_raw.astype(jnp.float32).reshape(b, n, 2, SSD_HEADS)
                         + dt_bias.astype(jnp.float32))
    return xs, bm, cm, dt.reshape(b, n, 2, SSD_GROUPS, SSD_HPG)


def ssd_chunked_scan(xs, dt, a, bm, cm, h0):
    b, n = xs.shape[:2]
    nc = n // SSD_CHUNK
    q = SSD_CHUNK
    xs = xs.reshape(b, nc, q, SSD_GROUPS, SSD_HPG, SSD_HEAD_DIM)
    dt = dt.reshape(b, nc, q, SSD_GROUPS, SSD_HPG)
    bm = bm.reshape(b, nc, q, SSD_GROUPS, SSD_STATE)
    cm = cm.reshape(b, nc, q, SSD_GROUPS, SSD_STATE)
    acum = jnp.cumsum(dt * a, axis=2)
    xdt = xs * dt[..., None]
    ac = jnp.moveaxis(acum, 2, -1)
    seg = ac[..., :, None] - ac[..., None, :]
    lower = jnp.tril(jnp.ones((q, q), dtype=bool))
    decay = jnp.exp(jnp.where(lower, seg, -jnp.inf))
    cb = jnp.einsum('bcign,bcjgn->bcgij', cm, bm)
    y_diag = jnp.einsum('bcgkij,bcjgkp->bcigkp', cb[:, :, :, None] * decay, xdt)
    decay_end = jnp.exp(acum[:, :, -1:] - acum)
    states = jnp.einsum('bcjgn,bcjgkp->bcgkpn', bm, xdt * decay_end[..., None])
    chunk_decay = jnp.exp(acum[:, :, -1])

    def step(h, inp):
        st, dec = inp
        return h * dec[..., None, None] + st, h

    h_final, h_prev = lax.scan(step, h0, (jnp.moveaxis(states, 1, 0), jnp.moveaxis(chunk_decay, 1, 0)))
    h_prev = jnp.moveaxis(h_prev, 0, 1)
    y_off = jnp.einsum('bcign,bcgkpn->bcigkp', cm, h_prev) * jnp.exp(acum)[..., None]
    return (y_diag + y_off).reshape(b, n, SSD_GROUPS, SSD_HPG, SSD_HEAD_DIM), h_final


def ssd_bidir(xs, bm, cm, dt, a, h0_f, h0_b):
    y_f, h_f = ssd_chunked_scan(xs, dt[:, :, 0], a[0], bm, cm, h0_f)
    y_b, h_b = ssd_chunked_scan(flip_seq(xs), flip_seq(dt[:, :, 1]), a[1],
                                flip_seq(bm), flip_seq(cm), h0_b)
    return y_f + flip_seq(y_b), h_f, h_b


def s5_discretise(lam_re, lam_im, log_step, b_re, b_im):
    lam = lax.complex(lam_re.astype(jnp.float32), lam_im.astype(jnp.float32))
    delta = jnp.exp(log_step.astype(jnp.float32))[..., None]
    lam_bar = jnp.exp(lam * delta)
    bmat = lax.complex(b_re.astype(jnp.float32), b_im.astype(jnp.float32))
    b_bar = ((lam_bar - 1.0) / lam)[..., None] * bmat[None]
    return lam_bar, b_bar


def _linear_recurrence(left, right):
    a_l, b_l = left
    a_r, b_r = right
    return a_l * a_r, a_r * b_l + b_r


def s5_scan(u, lam_bar, b_bar, h0):
    bu = jnp.einsum('gpe,blge->blgp', b_bar, u.astype(jnp.float32).astype(jnp.complex64))
    bu = bu.at[:, 0].add(lam_bar * h0)
    a = jnp.broadcast_to(lam_bar, bu.shape)
    _, h = lax.associative_scan(_linear_recurrence, (a, bu), axis=1)
    return h, h[:, -1]


def s5_bidir(u, lam_bar, b_bar, h0_f, h0_b):
    h_f, last_f = s5_scan(u, lam_bar[0], b_bar[0], h0_f)
    h_b, last_b = s5_scan(flip_seq(u), lam_bar[1], b_bar[1], h0_b)
    return h_f + flip_seq(h_b), last_f, last_b


def token_mixing(h_lat, h_ctx, need_ctx, lam_init, w_in, da_lambda, da_subln,
                 conv_w, conv_b, dt_bias, a_log, ssd_d, ssd_norm,
                 lam_re, lam_im, log_step, b_re, b_im, c_re, c_im, s5_d, glu_w, glu_b,
                 w_branch, w_out):
    dtype = h_lat.dtype
    b, n_lat = h_lat.shape[:2]
    p_lat = h_lat @ w_in
    p_ctx = h_ctx @ w_in

    lf = da_lambda.astype(jnp.float32)
    lam = jnp.exp(jnp.sum(lf[0] * lf[1])) - jnp.exp(jnp.sum(lf[2] * lf[3])) + lam_init

    def qkv(p):
        m = p.shape[1]
        q = p[..., Q_OFF:K_OFF].reshape(b, m, DA_HEADS, 2, DA_HEAD_DIM)
        k = p[..., K_OFF:V_OFF].reshape(b, m, DA_HEADS, 2, DA_HEAD_DIM)
        v = p[..., V_OFF:Z_OFF].reshape(b, m, DA_HEADS, DA_V_DIM)
        return q, k, v

    def attn_post(o):
        return (rms_norm(o, da_subln) * (1.0 - lam_init)).reshape(o.shape[0], o.shape[1], DA_WIDTH)

    cos, sin = axial_rope_tables(n_lat)
    q_l, k_l, v_l = qkv(p_lat)
    q_l = apply_axial_rope(q_l, cos, sin)
    k_l = apply_axial_rope(k_l, cos, sin)
    q_c, k_c, v_c = qkv(p_ctx)
    y_attn_lat = attn_post(diff_attention_sweep(q_l, jnp.concatenate([k_c, k_l], axis=1),
                                                jnp.concatenate([v_c, v_l], axis=1), lam))

    a = -jnp.exp(a_log.astype(jnp.float32)).reshape(2, SSD_GROUPS, SSD_HPG)
    d_ssd = ssd_d.astype(jnp.float32).reshape(SSD_GROUPS, SSD_HPG, 1)

    def ssd_post(y, xs, p):
        y = (y + d_ssd * xs).reshape(b, y.shape[1], SSD_WIDTH).astype(dtype)
        return rms_norm(y * jax.nn.silu(p[..., Z_OFF:XBC_OFF]), ssd_norm)

    xs_c, bm_c, cm_c, dt_c = ssd_inputs(p_ctx[..., XBC_OFF:DT_OFF], p_ctx[..., DT_OFF:U_OFF],
                                        conv_w, conv_b, dt_bias)
    h_zero = jnp.zeros((b, SSD_GROUPS, SSD_HPG, SSD_HEAD_DIM, SSD_STATE), jnp.float32)
    y_ssd_c, hf_c, hb_c = ssd_bidir(xs_c, bm_c, cm_c, dt_c, a, h_zero, h_zero)
    xs_l, bm_l, cm_l, dt_l = ssd_inputs(p_lat[..., XBC_OFF:DT_OFF], p_lat[..., DT_OFF:U_OFF],
                                        conv_w, conv_b, dt_bias)
    y_ssd_l, _, _ = ssd_bidir(xs_l, bm_l, cm_l, dt_l, a, hf_c, hb_c)
    y_ssd_lat = ssd_post(y_ssd_l, xs_l, p_lat)

    lam_bar, b_bar = s5_discretise(lam_re, lam_im, log_step, b_re, b_im)
    cmat = lax.complex(c_re.astype(jnp.float32), c_im.astype(jnp.float32))
    d_s5 = s5_d.astype(jnp.float32).reshape(S5_GROUPS, S5_GROUP)

    def s5_post(hs, u):
        y = jnp.real(jnp.einsum('gep,blgp->blge', cmat, hs)) + d_s5 * u.astype(jnp.float32)
        y = jax.nn.gelu(y.reshape(b, u.shape[1], S5_WIDTH).astype(dtype))
        ab = y @ glu_w + glu_b
        return ab[..., :S5_WIDTH] * jax.nn.sigmoid(ab[..., S5_WIDTH:])

    u_c = p_ctx[..., U_OFF:GATE_OFF].reshape(b, h_ctx.shape[1], S5_GROUPS, S5_GROUP)
    s_zero = jnp.zeros((b, S5_GROUPS, S5_STATE), jnp.complex64)
    hs_c, lf_c, lb_c = s5_bidir(u_c, lam_bar, b_bar, s_zero, s_zero)
    u_l = p_lat[..., U_OFF:GATE_OFF].reshape(b, n_lat, S5_GROUPS, S5_GROUP)
    hs_l, _, _ = s5_bidir(u_l, lam_bar, b_bar, lf_c, lb_c)
    y_s5_lat = s5_post(hs_l, u_l)

    def merge(p, y_a, y_b, y_c):
        m = p.shape[1]
        ys = jnp.stack([y_a, y_b, y_c], axis=2)
        branches = jnp.einsum('blnw,nwd->blnd', ys, w_branch)
        gates = jax.nn.sigmoid(p[..., GATE_OFF:].reshape(b, m, N_BRANCH, D_MODEL))
        return jnp.sum(gates * branches, axis=2) @ w_out

    out_lat = merge(p_lat, y_attn_lat, y_ssd_lat, y_s5_lat)
    out_ctx = None
    if need_ctx:
        y_attn_c = attn_post(diff_attn_block(q_c, k_c, v_c, lam))
        out_ctx = merge(p_ctx, y_attn_c, ssd_post(y_ssd_c, xs_c, p_ctx), s5_post(hs_c, u_c))
    return out_lat, out_ctx


def setup_inputs(seed: int = 0) -> dict:
    key = jax.random.key(seed)
    ks = iter(jax.random.split(key, 40))

    def nrm(shape, scale):
        return jax.random.normal(next(ks), shape, jnp.float32) * scale

    def gain(shape):
        return 1.0 + nrm(shape, 0.02)

    def unif(shape, lo, hi):
        return jax.random.uniform(next(ks), shape, jnp.float32, lo, hi)

    L = DEPTH
    x = nrm((BATCH, SEQ, D_MODEL), 1.0)
    c = nrm((BATCH, D_MODEL), 1.0)
    ctx = nrm((BATCH, CTX_LEN, D_MODEL), 1.0)
    c_ctx = nrm((D_MODEL,), 1.0)
    ada_w = nrm((L, D_MODEL, 6 * D_MODEL), 0.5 * D_MODEL ** -0.5)
    ada_b = nrm((L, 6 * D_MODEL), 0.02)
    norm_mix_pre = gain((L, D_MODEL))
    norm_mix_post = gain((L, D_MODEL))
    norm_ffn_pre = gain((L, D_MODEL))
    norm_ffn_post = gain((L, D_MODEL))
    w_in = nrm((L, D_MODEL, N_IN), D_MODEL ** -0.5)
    da_lambda = nrm((L, 4, DA_HEAD_DIM), 0.1)
    da_subln = gain((L, DA_V_DIM))
    ssd_conv_w = nrm((L, SSD_CONV, SSD_XBC), SSD_CONV ** -0.5)
    ssd_conv_b = nrm((L, SSD_XBC), 0.01)
    dt0 = jnp.exp(unif((L, 2, SSD_HEADS), math.log(1e-3), math.log(1e-1)))
    ssd_dt_bias = dt0 + jnp.log(-jnp.expm1(-dt0))
    ssd_a_log = jnp.log(unif((L, 2, SSD_HEADS), 1.0, 16.0))
    ssd_d = gain((L, SSD_HEADS))
    ssd_norm = gain((L, SSD_WIDTH))
    s5_lam_re = -0.5 + nrm((L, 2, S5_GROUPS, S5_STATE), 0.01)
    s5_lam_im = (math.pi * jnp.arange(S5_STATE, dtype=jnp.float32)) + nrm((L, 2, S5_GROUPS, S5_STATE), 0.01)
    s5_log_step = unif((L, 2, S5_GROUPS), math.log(1e-3), math.log(1e-1))
    s5_b_re = nrm((L, S5_GROUPS, S5_STATE, S5_GROUP), (2.0 * S5_GROUP) ** -0.5)
    s5_b_im = nrm((L, S5_GROUPS, S5_STATE, S5_GROUP), (2.0 * S5_GROUP) ** -0.5)
    s5_c_re = nrm((L, S5_GROUPS, S5_GROUP, S5_STATE), (2.0 * S5_STATE) ** -0.5)
    s5_c_im = nrm((L, S5_GROUPS, S5_GROUP, S5_STATE), (2.0 * S5_STATE) ** -0.5)
    s5_d = nrm((L, S5_WIDTH), 1.0)
    s5_glu_w = nrm((L, S5_WIDTH, 2 * S5_WIDTH), S5_WIDTH ** -0.5)
    s5_glu_b = nrm((L, 2 * S5_WIDTH), 0.01)
    w_branch = nrm((L, N_BRANCH, DA_WIDTH, D_MODEL), DA_WIDTH ** -0.5)
    w_out = nrm((L, D_MODEL, D_MODEL), D_MODEL ** -0.5)
    ffn_w_gate = nrm((L, D_MODEL, D_FF), D_MODEL ** -0.5)
    ffn_w_up = nrm((L, D_MODEL, D_FF), D_MODEL ** -0.5)
    ffn_w_down = nrm((L, D_FF, D_MODEL), D_FF ** -0.5)
    return {'x': x, 'c': c, 'ctx': ctx, 'c_ctx': c_ctx, 'ada_w': ada_w, 'ada_b': ada_b,
            'norm_mix_pre': norm_mix_pre, 'norm_mix_post': norm_mix_post,
            'norm_ffn_pre': norm_ffn_pre, 'norm_ffn_post': norm_ffn_post,
            'w_in': w_in, 'da_lambda': da_lambda, 'da_subln': da_subln,
            'ssd_conv_w': ssd_conv_w, 'ssd_conv_b': ssd_conv_b, 'ssd_dt_bias': ssd_dt_bias,
            'ssd_a_log': ssd_a_log, 'ssd_d': ssd_d, 'ssd_norm': ssd_norm,
            's5_lam_re': s5_lam_re, 's5_lam_im': s5_lam_im, 's5_log_step': s5_log_step,
            's5_b_re': s5_b_re, 's5_b_im': s5_b_im, 's5_c_re': s5_c_re, 's5_c_im': s5_c_im,
            's5_d': s5_d, 's5_glu_w': s5_glu_w, 's5_glu_b': s5_glu_b,
            'w_branch': w_branch, 'w_out': w_out,
            'ffn_w_gate': ffn_w_gate, 'ffn_w_up': ffn_w_up, 'ffn_w_down': ffn_w_down}


def reference(x, c, ctx, c_ctx, ada_w, ada_b, norm_mix_pre, norm_mix_post, norm_ffn_pre, norm_ffn_post,
              w_in, da_lambda, da_subln, ssd_conv_w, ssd_conv_b, ssd_dt_bias, ssd_a_log, ssd_d, ssd_norm,
              s5_lam_re, s5_lam_im, s5_log_step, s5_b_re, s5_b_im, s5_c_re, s5_c_im, s5_d,
              s5_glu_w, s5_glu_b, w_branch, w_out, ffn_w_gate, ffn_w_up, ffn_w_down):
    xc = ctx
    silu_c = jax.nn.silu(c)
    silu_cc = jax.nn.silu(c_ctx)
    for l in range(DEPTH):
        last = l == DEPTH - 1
        lam_init = 0.8 - 0.6 * math.exp(-0.3 * l)
        mod_l = (silu_c @ ada_w[l] + ada_b[l]).reshape(x.shape[0], 1, 6, D_MODEL)
        mod_c = (silu_cc @ ada_w[l] + ada_b[l]).reshape(6, D_MODEL)
        sh1, sc1, g1, sh2, sc2, g2 = [mod_l[:, :, i] for i in range(6)]
        csh1, csc1, cg1, csh2, csc2, cg2 = [mod_c[i] for i in range(6)]

        h = modulate(rms_norm(x, norm_mix_pre[l]), sh1, sc1)
        hc = modulate(rms_norm(xc, norm_mix_pre[l]), csh1, csc1)
        o_lat, o_ctx = token_mixing(h, hc, not last, lam_init, w_in[l], da_lambda[l], da_subln[l],
                                    ssd_conv_w[l], ssd_conv_b[l], ssd_dt_bias[l], ssd_a_log[l],
                                    ssd_d[l], ssd_norm[l],
                                    s5_lam_re[l], s5_lam_im[l], s5_log_step[l], s5_b_re[l], s5_b_im[l],
                                    s5_c_re[l], s5_c_im[l], s5_d[l], s5_glu_w[l], s5_glu_b[l],
                                    w_branch[l], w_out[l])
        x = x + g1 * rms_norm(o_lat, norm_mix_post[l])
        h = modulate(rms_norm(x, norm_ffn_pre[l]), sh2, sc2)
        x = x + g2 * rms_norm(swiglu(h, ffn_w_gate[l], ffn_w_up[l], ffn_w_down[l]), norm_ffn_post[l])

        if not last:
            xc = xc + cg1 * rms_norm(o_ctx, norm_mix_post[l])
            hc = modulate(rms_norm(xc, norm_ffn_pre[l]), csh2, csc2)
            xc = xc + cg2 * rms_norm(swiglu(hc, ffn_w_gate[l], ffn_w_up[l], ffn_w_down[l]),
                                     norm_ffn_post[l])
    return x
```

```cpp
#include <hip/hip_runtime.h>
#include <hip/hip_cooperative_groups.h>
#include <cstdio>
#include <cstdint>
namespace cg = cooperative_groups;

__device__ __forceinline__ int otid() { int t = threadIdx.x; asm volatile("" : "+v"(t)); return t; }
__device__ __forceinline__ int obid() { int t = blockIdx.x; asm volatile("" : "+s"(t)); return t; }
namespace pg8 {
#define PG8_LAS __attribute__((address_space(3)))
typedef unsigned short bf16_t;
typedef short bf16x8 __attribute__((ext_vector_type(8)));
typedef float f32x4 __attribute__((ext_vector_type(4)));
typedef unsigned u32x4 __attribute__((ext_vector_type(4)));
constexpr int BM = 256, BK = 64, HALF = 128, HTB = HALF * BK * 2, STAGE_BYTES = 8 * HTB, NXCD = 8, WGM = 8;

__host__ __device__ __forceinline__ int lds_byte(int r, int c) { const int st = (r >> 4) * 2 + (c >> 5), rr = r & 15, cc = c & 31, ob = rr * 64 + cc * 2; return st * 1024 + (ob ^ (((ob >> 9) & 1) << 5)); }
__host__ __device__ __forceinline__ void stage_rc(int b, int& R, int& C) { const int st = b / 1024, sb = b % 1024, swz = sb ^ (((sb >> 9) & 1) << 5); R = (st >> 1) * 16 + swz / 64; C = (st & 1) * 32 + (swz % 64) / 2; }
__host__ __device__ __forceinline__ int perm32(int rho) { const int n = rho >> 4, i = rho & 15; return 8 * (i >> 2) + 4 * n + (i & 3); }

struct Unit { int pm, pn; };
struct Gemm { const bf16_t* A; const bf16_t* Bt; int M, N, K; };

struct StaticOrder {
    int nM, nN, nwg, G, c;
    __host__ __device__ void init(int M, int N, int G_, int c_) { nM = M / BM; nN = N / BM; nwg = nM * nN; G = G_; c = c_; }
    __host__ __device__ bool next(int i, Unit& u) const {
        const long L = (long)i * G + c; if (L >= nwg) return false;
        int wgid = (int)L; { const int q = nwg / NXCD, r = nwg % NXCD, xcd = wgid % NXCD, off = wgid / NXCD; wgid = (xcd < r ? xcd * (q + 1) : r * (q + 1) + (xcd - r) * q) + off; }
        const int nig = WGM * nN, gid = wgid / nig, fm = gid * WGM, gsz = (nM - fm) < WGM ? (nM - fm) : WGM;
        u.pm = fm + ((wgid % nig) % gsz); u.pn = (wgid % nig) / gsz; return true;
    }
    __device__ __forceinline__ void a_ready(const Unit&) const {}
    __device__ __forceinline__ void done(const Unit&) const {}
};
struct MultiOrder {
    StaticOrder so; int nN1, mstride;
    __host__ __device__ void init(int M, int N1, int ng, int mstride_, int G_, int c_) { so.init(M, N1 * ng, G_, c_); nN1 = N1 / BM; mstride = mstride_; }
    __host__ __device__ bool next(int i, Unit& u) const { if (!so.next(i, u)) return false; const int gi = u.pn / nN1; u.pm += gi * mstride; return true; }
    __device__ __forceinline__ void a_ready(const Unit&) const {}
    __device__ __forceinline__ void done(const Unit&) const {}
};

typedef float f32x2 __attribute__((ext_vector_type(2)));
typedef __bf16 bf16x2_t __attribute__((ext_vector_type(2)));
__device__ __forceinline__ unsigned cvt_pk_bf16(float lo, float hi) { f32x2 v = {lo, hi}; bf16x2_t b = __builtin_convertvector(v, bf16x2_t); return __builtin_bit_cast(unsigned, b); }

template <class Epi, class Sched, bool ALIGN_EPI = false, bool SP2 = false>
__device__ __forceinline__ void gemm_phase(PG8_LAS unsigned char* lds, const Gemm g, const Sched& S, const Epi& E) {
    const int tid = otid(), wid = __builtin_amdgcn_readfirstlane(tid >> 6), lane = tid & 63, wr = wid >> 2, wc = wid & 3, fr = lane & 15, fq = lane >> 4;
    const int K = g.K, nt = K / BK;
    unsigned voffA[2], voffB[2];
#pragma unroll
    for (int i = 0; i < 2; ++i) { int R, C; stage_rc(tid * 16 + i * 8192, R, C); const int Rb = Epi::PERM ? ((R & ~31) + perm32(R & 31)) : R;
        voffA[i] = (unsigned)(R * K + C) * 2u; voffB[i] = (unsigned)(Rb * K + C) * 2u; }
    const size_t kstep = (size_t)(BK * 2);
    const size_t hstep = (size_t)HALF * K * 2;
    const size_t tstep = 2 * hstep;
    const unsigned ldsw = (unsigned)wid * 1024u;
    const int aoff = lds_byte(wr * 64 + fr, fq * 8), boff = lds_byte(wc * 32 + fr, fq * 8);
#define PG8_SA(b, h) (((b) * 2 + (h)) * HTB)
#define PG8_SB(b, h) ((4 + (b) * 2 + (h)) * HTB)
#define PG8_STAGE(bufoff, gbase, voff) do { _Pragma("unroll") for (int _i = 0; _i < 2; ++_i) \
        __builtin_amdgcn_global_load_lds((const unsigned*)((const char*)(gbase) + (voff)[_i]), (PG8_LAS unsigned*)(lds + (bufoff) + ldsw + _i * 8192), 16, 0, 0); } while (0)
#define PG8_LDA(dst, b, h) do { _Pragma("unroll") for (int m = 0; m < 4; ++m) _Pragma("unroll") for (int k = 0; k < 2; ++k) dst[m][k] = *(const PG8_LAS bf16x8*)(lds + PG8_SA(b, h) + aoff + m * 2048 + k * 1024); } while (0)
#define PG8_LDB(dst, b, h) do { _Pragma("unroll") for (int n = 0; n < 2; ++n) _Pragma("unroll") for (int k = 0; k < 2; ++k) dst[n][k] = *(const PG8_LAS bf16x8*)(lds + PG8_SB(b, h) + boff + n * 2048 + k * 1024); } while (0)
#define PG8_MMA(ai, bj, At, Bt) do { __builtin_amdgcn_s_setprio(1); _Pragma("unroll") for (int m = 0; m < 4; ++m) _Pragma("unroll") for (int n = 0; n < 2; ++n) _Pragma("unroll") for (int k = 0; k < 2; ++k) \
        acc[ai][bj][m][n] = __builtin_amdgcn_mfma_f32_16x16x32_bf16(Bt[n][k], At[m][k], acc[ai][bj][m][n], 0, 0, 0); __builtin_amdgcn_s_setprio(0); } while (0)
#define PG8_WAIT_V(n) asm volatile("s_waitcnt vmcnt(" #n ")" ::: "memory")
#define PG8_WAIT_L(n) asm volatile("s_waitcnt lgkmcnt(" #n ")" ::: "memory")
#define PG8_BAR __builtin_amdgcn_s_barrier()
#define PG8_SCHED __builtin_amdgcn_sched_barrier(0)
    Unit cur, nxt; int ui = 0;
    if (!S.next(0, cur)) return;
    f32x4 acc[2][2][4][2];
#pragma unroll
    for (int a = 0; a < 2; ++a)
#pragma unroll
        for (int b = 0; b < 2; ++b)
#pragma unroll
            for (int m = 0; m < 4; ++m)
#pragma unroll
                for (int n = 0; n < 2; ++n) acc[a][b][m][n] = (f32x4){0.f, 0.f, 0.f, 0.f};
    bf16x8 At[4][2], B0[2][2], B1[2][2];
    const char* cA = (const char*)g.A + (size_t)cur.pm * tstep; const char* cB = (const char*)g.Bt + (size_t)cur.pn * tstep;
    S.a_ready(cur);
    if constexpr (SP2) {
        PG8_STAGE(PG8_SB(0, 0), cB, voffB); PG8_STAGE(PG8_SB(0, 1), cB + hstep, voffB); PG8_STAGE(PG8_SA(0, 0), cA, voffA); PG8_STAGE(PG8_SA(0, 1), cA + hstep, voffA);
        if (wr == 1) PG8_BAR;
        PG8_WAIT_V(2); PG8_BAR;
        PG8_STAGE(PG8_SB(1, 0), cB + kstep, voffB); PG8_STAGE(PG8_SA(1, 0), cA + kstep, voffA); PG8_STAGE(PG8_SB(1, 1), cB + hstep + kstep, voffB);
        PG8_WAIT_V(6); PG8_BAR;
    } else {
        PG8_STAGE(PG8_SB(0, 0), cB, voffB); PG8_STAGE(PG8_SA(0, 0), cA, voffA); PG8_STAGE(PG8_SB(0, 1), cB + hstep, voffB); PG8_STAGE(PG8_SA(0, 1), cA + hstep, voffA);
        if (wr == 1) PG8_BAR;
        PG8_WAIT_V(4); PG8_BAR;
        PG8_STAGE(PG8_SB(1, 0), cB + kstep, voffB); PG8_STAGE(PG8_SA(1, 0), cA + kstep, voffA); PG8_STAGE(PG8_SB(1, 1), cB + hstep + kstep, voffB);
        PG8_WAIT_V(6); PG8_BAR;
    }
    for (;;) {
        const bool has_next = S.next(ui + 1, nxt);
        const char* nA = has_next ? (const char*)g.A + (size_t)nxt.pm * tstep : cA; const char* nB = has_next ? (const char*)g.Bt + (size_t)nxt.pn * tstep : cB;
        for (int t = 0; t < nt; t += 2) {
            const bool last = (t == nt - 2);
            const char* a1 = cA + (size_t)(t + 1) * kstep;
            const char* a2 = last ? nA : cA + (size_t)(t + 2) * kstep; const char* b2 = last ? nB : cB + (size_t)(t + 2) * kstep;
            const char* a3 = a2 + kstep; const char* b3 = b2 + kstep;
            if (last && has_next) S.a_ready(nxt);
            if constexpr (SP2) {
            PG8_LDB(B0, 0, 0); PG8_LDB(B1, 0, 1); PG8_SCHED; PG8_LDA(At, 0, 0); PG8_STAGE(PG8_SA(1, 1), a1 + hstep, voffA);
            PG8_WAIT_V(8); PG8_WAIT_L(0); PG8_BAR; PG8_MMA(0, 0, At, B0); PG8_MMA(0, 1, At, B1); PG8_BAR; PG8_SCHED;
            PG8_LDA(At, 0, 1); PG8_STAGE(PG8_SB(0, 0), b2, voffB); PG8_STAGE(PG8_SB(0, 1), b2 + hstep, voffB); PG8_STAGE(PG8_SA(0, 0), a2, voffA);
            PG8_WAIT_V(8); PG8_WAIT_L(0); PG8_BAR; PG8_MMA(1, 0, At, B0); PG8_MMA(1, 1, At, B1); PG8_BAR; PG8_SCHED;
            PG8_LDB(B0, 1, 0); PG8_LDB(B1, 1, 1); PG8_SCHED; PG8_LDA(At, 1, 0); PG8_STAGE(PG8_SA(0, 1), a2 + hstep, voffA);
            PG8_WAIT_V(8); PG8_WAIT_L(0); PG8_BAR; PG8_MMA(0, 0, At, B0); PG8_MMA(0, 1, At, B1); PG8_BAR; PG8_SCHED;
            PG8_LDA(At, 1, 1); PG8_STAGE(PG8_SB(1, 0), b3, voffB); PG8_STAGE(PG8_SB(1, 1), b3 + hstep, voffB); PG8_STAGE(PG8_SA(1, 0), a3, voffA);
            PG8_WAIT_V(8); PG8_WAIT_L(0); PG8_BAR; PG8_MMA(1, 0, At, B0); PG8_MMA(1, 1, At, B1); PG8_BAR; PG8_SCHED;
            } else {
            PG8_LDB(B0, 0, 0); PG8_SCHED; PG8_LDA(At, 0, 0); PG8_STAGE(PG8_SA(1, 1), a1 + hstep, voffA);
            PG8_WAIT_L(8); PG8_BAR; PG8_WAIT_L(0); PG8_MMA(0, 0, At, B0); PG8_BAR; PG8_SCHED;
            PG8_LDB(B1, 0, 1); PG8_STAGE(PG8_SB(0, 0), b2, voffB);
            PG8_BAR; PG8_WAIT_L(0); PG8_MMA(0, 1, At, B1); PG8_BAR;
            PG8_LDA(At, 0, 1); PG8_STAGE(PG8_SA(0, 0), a2, voffA);
            PG8_BAR; PG8_WAIT_L(0); PG8_MMA(1, 0, At, B0); PG8_BAR; PG8_SCHED;
            PG8_STAGE(PG8_SB(0, 1), b2 + hstep, voffB);
            PG8_WAIT_V(6); PG8_BAR; PG8_MMA(1, 1, At, B1); PG8_BAR;
            PG8_LDB(B0, 1, 0); PG8_SCHED; PG8_LDA(At, 1, 0); PG8_STAGE(PG8_SA(0, 1), a2 + hstep, voffA);
            PG8_WAIT_L(8); PG8_BAR; PG8_WAIT_L(0); PG8_MMA(0, 0, At, B0); PG8_BAR; PG8_SCHED;
            PG8_LDB(B1, 1, 1); PG8_STAGE(PG8_SB(1, 0), b3, voffB);
            PG8_BAR; PG8_WAIT_L(0); PG8_MMA(0, 1, At, B1); PG8_BAR;
            PG8_LDA(At, 1, 1); PG8_STAGE(PG8_SA(1, 0), a3, voffA);
            PG8_BAR; PG8_WAIT_L(0); PG8_MMA(1, 0, At, B0); PG8_BAR; PG8_SCHED;
            PG8_STAGE(PG8_SB(1, 1), b3 + hstep, voffB);
            PG8_WAIT_V(6); PG8_BAR; PG8_MMA(1, 1, At, B1); PG8_BAR;
            }
        }
        if constexpr (ALIGN_EPI) { if (wr == 0) PG8_BAR; }
        E(acc, cur, wr, wc, fr, fq); S.done(cur);
        if (!has_next) break;
#pragma unroll
        for (int a = 0; a < 2; ++a)
#pragma unroll
            for (int b = 0; b < 2; ++b)
#pragma unroll
                for (int m = 0; m < 4; ++m)
#pragma unroll
                    for (int n = 0; n < 2; ++n) acc[a][b][m][n] = (f32x4){0.f, 0.f, 0.f, 0.f};
        cur = nxt; cA = nA; cB = nB; ++ui;
        if constexpr (ALIGN_EPI) { if (wr == 1) PG8_BAR; }
    }
    PG8_WAIT_V(0);
    if constexpr (!ALIGN_EPI) { if (wr == 0) PG8_BAR; }
    PG8_BAR;
#undef PG8_SA
#undef PG8_SB
#undef PG8_STAGE
#undef PG8_LDA
#undef PG8_LDB
#undef PG8_MMA
#undef PG8_WAIT_V
#undef PG8_WAIT_L
#undef PG8_BAR
#undef PG8_SCHED
}
}

using pg8::bf16_t; using pg8::f32x4; using pg8::u32x4; using pg8::bf16x8;
typedef float f32x16 __attribute__((ext_vector_type(16)));
typedef float f32x2v __attribute__((ext_vector_type(2)));
typedef unsigned u32x2 __attribute__((ext_vector_type(2)));
constexpr int D = 2048, SEQ = 4096, CTXL = 256, MLAT = 8192, MCTX = 512, MROWS = 8704, MT = 34;
constexpr int NIN = 12832, NINP = 13056;
constexpr int QOFF = 0, KOFF = 1024, VOFF = 2048, ZOFF = 3072, XBCOFF = 4096, DTOFF = 5632, UOFF = 5664, GATEOFF = 6688;
constexpr int DFF = 5632, KVL = 4352, NCH = 17;
constexpr float EPS = 1e-6f;
constexpr int NT = 512, NWAVES = 8;
constexpr int LDS_BYTES = 147456;
#ifndef PROBE_DUP
#define PROBE_DUP 0
#endif

constexpr size_t MiB = 1u << 20;
constexpr size_t WS_WIN = 0;
constexpr size_t WS_WSTK = 51 * MiB;
constexpr size_t WS_WOUT = 67 * MiB;
constexpr size_t WS_WGU = 75 * MiB;
constexpr size_t WS_WDN = 119 * MiB;
constexpr size_t WS_P = 141 * MiB;
constexpr size_t WS_H = 358 * MiB;
constexpr size_t WS_XC = 392 * MiB;
constexpr size_t WS_AST = 396 * MiB;
constexpr size_t WS_DTV = 464 * MiB;
constexpr size_t WS_MOD = 467 * MiB;
constexpr size_t WS_R2 = 468 * MiB;
constexpr size_t WS_QR = WS_R2;
constexpr size_t WS_KR = WS_R2 + 17 * MiB;
constexpr size_t WS_VT = WS_R2 + 34 * MiB;
constexpr size_t WS_XBC = WS_R2 + 51 * MiB;
constexpr size_t WS_YSSD = WS_R2 + 102 * MiB;
constexpr size_t WS_YS5 = WS_R2 + 170 * MiB;
constexpr size_t WS_HINB = WS_R2 + 238 * MiB;
constexpr size_t WS_LA = WS_R2 + 255 * MiB;
constexpr size_t WS_BN = WS_R2 + 257 * MiB;
constexpr size_t WS_CN = WS_R2 + 266 * MiB;
constexpr size_t WS_BT = WS_R2 + 275 * MiB;
constexpr size_t WS_XDT = WS_R2 + 284 * MiB;
constexpr size_t WS_BR0 = WS_R2;
constexpr size_t WS_BR1 = WS_R2 + 34 * MiB;
constexpr size_t WS_MRG = WS_R2 + 68 * MiB;
constexpr size_t WS_O = WS_R2 + 102 * MiB;
constexpr size_t WS_BAR = WS_R2 + 318 * MiB;
constexpr size_t WS_BAR_BYTES = 16384;
constexpr size_t WS_END = WS_BAR + 1 * MiB;

struct Args { const float* in[34]; float* out; unsigned char* ws; };

__device__ __forceinline__ float bf2f(unsigned v) { return __uint_as_float(v << 16); }
__device__ __forceinline__ unsigned pk2(float lo, float hi) { return pg8::cvt_pk_bf16(lo, hi); }
__device__ __forceinline__ void unpack8(const u32x4 w, float* f) {
    f[0] = __uint_as_float(w.x << 16); f[1] = __uint_as_float(w.x & 0xffff0000u); f[2] = __uint_as_float(w.y << 16); f[3] = __uint_as_float(w.y & 0xffff0000u);
    f[4] = __uint_as_float(w.z << 16); f[5] = __uint_as_float(w.z & 0xffff0000u); f[6] = __uint_as_float(w.w << 16); f[7] = __uint_as_float(w.w & 0xffff0000u);
}
__device__ __forceinline__ float sigmoidf_(float x) { return 1.f / (1.f + __expf(-x)); }
__device__ __forceinline__ float siluf_(float x) { return x / (1.f + __expf(-x)); }
__device__ __forceinline__ float wave_sum(float v) {
#pragma unroll
    for (int o = 1; o < 64; o <<= 1) v += __shfl_xor(v, o);
    return v;
}

struct EpiStore16 {
    static constexpr bool PERM = true;
    bf16_t* O; int ldc;
    __device__ __forceinline__ void operator()(const f32x4 (&acc)[2][2][4][2], const pg8::Unit& u, int wr, int wc, int fr, int fq) const {
        const int row0 = (u.pm % MT) * 256 + wr * 64 + fr, col0 = u.pn * 256 + wc * 32 + 8 * fq;
#pragma unroll
        for (int ai = 0; ai < 2; ++ai)
#pragma unroll
            for (int m = 0; m < 4; ++m) { bf16_t* rowp = O + (size_t)(row0 + ai * 128 + m * 16) * ldc + col0;
#pragma unroll
                for (int bj = 0; bj < 2; ++bj) { const f32x4 v0 = acc[ai][bj][m][0], v1 = acc[ai][bj][m][1];
                    u32x4 w; w.x = pk2(v0[0], v0[1]); w.y = pk2(v0[2], v0[3]); w.z = pk2(v1[0], v1[1]); w.w = pk2(v1[2], v1[3]);
                    *(u32x4*)(rowp + bj * 128) = w; } }
    }
};
template <int MODE> struct EpiPair {
    static constexpr bool PERM = true;
    bf16_t* O; int ldc; const float* bias;
    __device__ __forceinline__ void operator()(const f32x4 (&acc)[2][2][4][2], const pg8::Unit& u, int wr, int wc, int fr, int fq) const {
        const int row0 = (u.pm % MT) * 256 + wr * 64 + fr, col0 = u.pn * 128 + wc * 32 + 8 * fq;
        float ba[8], bb[8];
#pragma unroll
        for (int j = 0; j < 8; ++j) { ba[j] = (MODE == 1) ? bias[col0 + j] : 0.f; bb[j] = (MODE == 1) ? bias[1024 + col0 + j] : 0.f; }
#pragma unroll
        for (int ai = 0; ai < 2; ++ai)
#pragma unroll
            for (int m = 0; m < 4; ++m) { bf16_t* rowp = O + (size_t)(row0 + ai * 128 + m * 16) * ldc + col0;
                float o[8];
#pragma unroll
                for (int n = 0; n < 2; ++n)
#pragma unroll
                    for (int j = 0; j < 4; ++j) { const float a = acc[ai][0][m][n][j] + ba[4 * n + j], b = acc[ai][1][m][n][j] + bb[4 * n + j];
                        o[4 * n + j] = (MODE == 0) ? siluf_(a) * b : a * sigmoidf_(b); }
                u32x4 w; w.x = pk2(o[0], o[1]); w.y = pk2(o[2], o[3]); w.z = pk2(o[4], o[5]); w.w = pk2(o[6], o[7]);
                *(u32x4*)rowp = w; }
    }
};
struct EpiF32 {
    static constexpr bool PERM = false;
    float* O; int ldc;
    __device__ __forceinline__ void operator()(const f32x4 (&acc)[2][2][4][2], const pg8::Unit& u, int wr, int wc, int fr, int fq) const {
        const int row0 = (u.pm % MT) * 256 + wr * 64 + fr, col0 = u.pn * 256 + wc * 32 + 4 * fq;
#pragma unroll
        for (int ai = 0; ai < 2; ++ai)
#pragma unroll
            for (int m = 0; m < 4; ++m) { float* rowp = O + (size_t)(row0 + ai * 128 + m * 16) * ldc + col0;
#pragma unroll
                for (int bj = 0; bj < 2; ++bj)
#pragma unroll
                    for (int n = 0; n < 2; ++n) *(f32x4*)(rowp + bj * 128 + n * 16) = acc[ai][bj][m][n]; }
    }
};
struct EpiG1 {
    static constexpr bool PERM = true;
    bf16_t* ys5; const float* glu_bias; bf16_t* br0; bf16_t* br1; const bf16_t* P;
    __device__ __forceinline__ void operator()(const f32x4 (&acc)[2][2][4][2], const pg8::Unit& u, int wr, int wc, int fr, int fq) const {
        const int gi = u.pn >> 3, pn = u.pn & 7;
        if (gi == 0) { pg8::Unit u2; u2.pm = u.pm; u2.pn = pn; EpiPair<1> e{ys5, 1024, glu_bias}; e(acc, u2, wr, wc, fr, fq); return; }
        bf16_t* br = (gi == 1) ? br0 : br1;
        const int row0 = (u.pm % MT) * 256 + wr * 64 + fr, col0 = pn * 256 + wc * 32 + 8 * fq;
#pragma unroll
        for (int ai = 0; ai < 2; ++ai)
#pragma unroll
            for (int m = 0; m < 4; ++m) { const int row = row0 + ai * 128 + m * 16;
#pragma unroll
                for (int bj = 0; bj < 2; ++bj) { const int col = col0 + bj * 128;
                    const u32x4 gw = *(const u32x4*)(P + (size_t)row * NINP + GATEOFF + (gi - 1) * 2048 + col); float gt[8]; unpack8(gw, gt);
                    const f32x4 v0 = acc[ai][bj][m][0], v1 = acc[ai][bj][m][1];
                    float o[8];
#pragma unroll
                    for (int j = 0; j < 4; ++j) { o[j] = sigmoidf_(gt[j]) * v0[j]; o[4 + j] = sigmoidf_(gt[4 + j]) * v1[j]; }
                    u32x4 w; w.x = pk2(o[0], o[1]); w.y = pk2(o[2], o[3]); w.z = pk2(o[4], o[5]); w.w = pk2(o[6], o[7]);
                    *(u32x4*)(br + (size_t)row * D + col) = w; } }
    }
};
struct EpiG2 {
    static constexpr bool PERM = true;
    bf16_t* mrg; const bf16_t* br0; const bf16_t* br1; const bf16_t* P;
    __device__ __forceinline__ void operator()(const f32x4 (&acc)[2][2][4][2], const pg8::Unit& u, int wr, int wc, int fr, int fq) const {
        const int row0 = (u.pm % MT) * 256 + wr * 64 + fr, col0 = u.pn * 256 + wc * 32 + 8 * fq;
#pragma unroll
        for (int ai = 0; ai < 2; ++ai)
#pragma unroll
            for (int m = 0; m < 4; ++m) { const int row = row0 + ai * 128 + m * 16;
#pragma unroll
                for (int bj = 0; bj < 2; ++bj) { const int col = col0 + bj * 128;
                    const u32x4 gw = *(const u32x4*)(P + (size_t)row * NINP + GATEOFF + 2 * 2048 + col); float gt[8]; unpack8(gw, gt);
                    const u32x4 w0 = *(const u32x4*)(br0 + (size_t)row * D + col); float b0[8]; unpack8(w0, b0);
                    const u32x4 w1 = *(const u32x4*)(br1 + (size_t)row * D + col); float b1[8]; unpack8(w1, b1);
                    const f32x4 v0 = acc[ai][bj][m][0], v1 = acc[ai][bj][m][1];
                    float o[8];
#pragma unroll
                    for (int j = 0; j < 4; ++j) { o[j] = b0[j] + b1[j] + sigmoidf_(gt[j]) * v0[j]; o[4 + j] = b0[4 + j] + b1[4 + j] + sigmoidf_(gt[4 + j]) * v1[j]; }
                    u32x4 w; w.x = pk2(o[0], o[1]); w.y = pk2(o[2], o[3]); w.z = pk2(o[4], o[5]); w.w = pk2(o[6], o[7]);
                    *(u32x4*)(mrg + (size_t)row * D + col) = w; } }
    }
};

__device__ __forceinline__ void mod_phase(const Args& a, float* lds, float* modv, int g0, int g1, int nblk) {
    const int tid = otid();
    const float* c = a.in[1]; const float* cc = a.in[3]; const float* W = a.in[4]; const float* bvec = a.in[5];
    bool staged = false;
    const int bxm = obid(); if (bxm >= nblk) return;
    for (int gidx = g0 + bxm; gidx < g1; gidx += nblk) {
        if (!staged) {
            for (int i = tid; i < 3 * 2048; i += NT) { const int v = i >> 11, k = i & 2047; const float x = (v < 2) ? c[v * 2048 + k] : cc[k]; lds[i] = siluf_(x); }
            staged = true;
        }
        __syncthreads();
        const int l = gidx >> 7, j0 = (gidx & 127) * 96;
        const int kg = tid / 24, cl = tid % 24;
        float acc[3][4];
#pragma unroll
        for (int v = 0; v < 3; ++v)
#pragma unroll
            for (int j = 0; j < 4; ++j) acc[v][j] = 0.f;
        if (kg < 21) {
            const float* wp = W + (size_t)l * 2048 * 12288 + j0 + 4 * cl;
#pragma unroll 14
            for (int k = kg; k < 2048; k += 21) {
                const f32x4 w = *(const f32x4*)(wp + (size_t)k * 12288);
                const float s0 = lds[k], s1 = lds[2048 + k], s2 = lds[4096 + k];
#pragma unroll
                for (int j = 0; j < 4; ++j) { acc[0][j] += s0 * w[j]; acc[1][j] += s1 * w[j]; acc[2][j] += s2 * w[j]; }
            }
            float* red = lds + 6144;
#pragma unroll
            for (int v = 0; v < 3; ++v)
#pragma unroll
                for (int j = 0; j < 4; ++j) red[(kg * 3 + v) * 96 + 4 * cl + j] = acc[v][j];
        }
        __syncthreads();
        if (tid < 288) { const int v = tid / 96, cidx = tid % 96; float s = bvec[l * 12288 + j0 + cidx];
            for (int g = 0; g < 21; ++g) s += lds[6144 + (g * 3 + v) * 96 + cidx];
            modv[(l * 3 + v) * 12288 + j0 + cidx] = s; }
        __syncthreads();
    }
}

__device__ __forceinline__ void transpose_item(const float* W, int K, int N, bf16_t* WT, int k0, int n0, int drow0, float* scr, int lane) {
    float tv[32];
#pragma unroll
    for (int i = 0; i < 32; ++i) { const int kk = 2 * i + (lane >> 5); tv[i] = W[(size_t)(k0 + kk) * N + n0 + (lane & 31)]; }
#pragma unroll
    for (int i = 0; i < 32; ++i) { const int kk = 2 * i + (lane >> 5); scr[kk * 33 + (lane & 31)] = tv[i]; }
    asm volatile("s_waitcnt vmcnt(0) lgkmcnt(0)" ::: "memory");
    const int c = lane & 7;
#pragma unroll
    for (int j = 0; j < 4; ++j) { const int n = (lane >> 3) + 8 * j; const float* s = scr + (8 * c) * 33 + n;
        u32x4 o; o.x = pk2(s[0 * 33], s[1 * 33]); o.y = pk2(s[2 * 33], s[3 * 33]); o.z = pk2(s[4 * 33], s[5 * 33]); o.w = pk2(s[6 * 33], s[7 * 33]);
        *(u32x4*)(WT + (size_t)(drow0 + n) * K + k0 + 8 * c) = o; }
    asm volatile("s_waitcnt lgkmcnt(0)" ::: "memory");
}
__device__ __forceinline__ int pair_row(int n0, int part) { return (n0 >> 7) * 256 + part * 128 + (n0 & 127); }
__device__ __forceinline__ void wconv_phase(const Args& a, int l, float* lds, int parts = 31, int blk0 = 0, int nblk = 1 << 30) {
    const int tid = otid(), lane = tid & 63, wave = tid >> 6;
    float* scr = lds + wave * 4096;
    const int bxw = obid();
    const int bend = ((int)gridDim.x < nblk) ? (int)gridDim.x : nblk;
    if (bxw < blk0 || bxw >= bend) return;
    const int gw = (bxw - blk0) * NWAVES + wave, NGW = (bend - blk0) * NWAVES;
    unsigned char* ws = a.ws;
    constexpr int I_IN = 32 * 401, I_GLU = 16 * 64, I_WB = 3 * 16 * 64, I_OUT = 32 * 64, I_G = 32 * 176, I_DN = 88 * 64;
    constexpr int TOTAL = I_IN + I_GLU + I_WB + I_OUT + 2 * I_G + I_DN;
    for (int it = gw; it < TOTAL; it += NGW) {
        int r = it;
        if (r < I_IN) { if (!(parts & (1 | 32 | 64))) { it += (I_IN - r - 1) / NGW * NGW; continue; }
            if (!((parts & 1) || ((parts & 32) && r < I_IN / 2) || ((parts & 64) && r >= I_IN / 2))) continue;
            const int kb = r / 401, nb = r % 401; transpose_item(a.in[10] + (size_t)l * 2048 * NIN, 2048, NIN, (bf16_t*)(ws + WS_WIN), 64 * kb, 32 * nb, 32 * nb, scr, lane); continue; } r -= I_IN;
        if (r < I_GLU) { if (!(parts & 2)) continue; const int kb = r / 64, nb = r % 64, n0 = 32 * nb; const int dr = (n0 < 1024) ? pair_row(n0, 0) : pair_row(n0 - 1024, 1);
            transpose_item(a.in[27] + (size_t)l * 1024 * 2048, 1024, 2048, (bf16_t*)(ws + WS_WSTK), 64 * kb, n0, dr, scr, lane); continue; } r -= I_GLU;
        if (r < I_WB) { if (!(parts & 2)) continue; const int bi = r / 1024, rr = r % 1024, kb = rr / 64, nb = rr % 64;
            transpose_item(a.in[29] + ((size_t)l * 3 + bi) * 1024 * 2048, 1024, 2048, (bf16_t*)(ws + WS_WSTK) + (size_t)(1 + bi) * 2048 * 1024, 64 * kb, 32 * nb, 32 * nb, scr, lane); continue; } r -= I_WB;
        if (r < I_OUT) { if (!(parts & 4)) continue; const int kb = r / 64, nb = r % 64; transpose_item(a.in[30] + (size_t)l * 2048 * 2048, 2048, 2048, (bf16_t*)(ws + WS_WOUT), 64 * kb, 32 * nb, 32 * nb, scr, lane); continue; } r -= I_OUT;
        if (r < I_G) { if (!(parts & 8)) continue; const int kb = r / 176, nb = r % 176; transpose_item(a.in[31] + (size_t)l * 2048 * DFF, 2048, DFF, (bf16_t*)(ws + WS_WGU), 64 * kb, 32 * nb, pair_row(32 * nb, 0), scr, lane); continue; } r -= I_G;
        if (r < I_G) { if (!(parts & 8)) continue; const int kb = r / 176, nb = r % 176; transpose_item(a.in[32] + (size_t)l * 2048 * DFF, 2048, DFF, (bf16_t*)(ws + WS_WGU), 64 * kb, 32 * nb, pair_row(32 * nb, 1), scr, lane); continue; } r -= I_G;
        if (parts & 16) { const int kb = r / 64, nb = r % 64; transpose_item(a.in[33] + (size_t)l * DFF * 2048, DFF, 2048, (bf16_t*)(ws + WS_WDN), 64 * kb, 32 * nb, 32 * nb, scr, lane); }
    }
}

struct RowPass {
    const float* src_lat; const float* src_ctx;
    float* dst_lat; float* dst_ctx;
    const bf16_t* o;
    const float* gpost; const float* gatev;
    bf16_t* h;
    const float* gpre; const float* shv; const float* scv;
    int nrows;
};
__device__ __forceinline__ void row_pass(const RowPass& rp) {
    const int tid = otid(), lane = tid & 63, wave = tid >> 6;
    const int gw = obid() * NWAVES + wave, NGW = gridDim.x * NWAVES;
    for (int row = gw; row < rp.nrows; row += NGW) {
        const int v = (row < MLAT) ? (row >> 12) : 2;
        const float* xs = (row < MLAT) ? rp.src_lat + (size_t)row * D : rp.src_ctx + (size_t)(row - MLAT) * D;
        f32x4 x[8];
#pragma unroll
        for (int j = 0; j < 8; ++j) x[j] = *(const f32x4*)(xs + 4 * (lane + 64 * j));
        if (rp.o) {
            const bf16_t* orow = rp.o + (size_t)row * D; f32x4 ov[8]; float ss = 0.f;
#pragma unroll
            for (int j = 0; j < 8; ++j) { const u32x2 w2 = *(const u32x2*)(orow + 4 * (lane + 64 * j));
                ov[j] = (f32x4){__uint_as_float(w2.x << 16), __uint_as_float(w2.x & 0xffff0000u), __uint_as_float(w2.y << 16), __uint_as_float(w2.y & 0xffff0000u)};
                ss += ov[j][0] * ov[j][0] + ov[j][1] * ov[j][1] + ov[j][2] * ov[j][2] + ov[j][3] * ov[j][3]; }
            const float rstd = rsqrtf(wave_sum(ss) * (1.f / D) + EPS);
#pragma unroll
            for (int j = 0; j < 8; ++j) { const int col = 4 * (lane + 64 * j); const f32x4 gp = *(const f32x4*)(rp.gpost + col); const f32x4 gt = *(const f32x4*)(rp.gatev + v * 12288 + col);
                x[j] = x[j] + gt * (ov[j] * rstd * gp); }
        }
        if (rp.dst_lat) { float* xd = (row < MLAT) ? rp.dst_lat + (size_t)row * D : rp.dst_ctx + (size_t)(row - MLAT) * D;
#pragma unroll
            for (int j = 0; j < 8; ++j) *(f32x4*)(xd + 4 * (lane + 64 * j)) = x[j]; }
        if (rp.h) {
            float ss = 0.f;
#pragma unroll
            for (int j = 0; j < 8; ++j) ss += x[j][0] * x[j][0] + x[j][1] * x[j][1] + x[j][2] * x[j][2] + x[j][3] * x[j][3];
            const float rstd = rsqrtf(wave_sum(ss) * (1.f / D) + EPS);
            bf16_t* hr = rp.h + (size_t)row * D;
#pragma unroll
            for (int j = 0; j < 8; ++j) { const int col = 4 * (lane + 64 * j); const f32x4 gp = *(const f32x4*)(rp.gpre + col); const f32x4 sh = *(const f32x4*)(rp.shv + v * 12288 + col); const f32x4 sc = *(const f32x4*)(rp.scv + v * 12288 + col);
                const f32x4 y = (x[j] * rstd * gp) * (sc + 1.f) + sh; u32x2 w; w.x = pk2(y[0], y[1]); w.y = pk2(y[2], y[3]); *(u32x2*)(hr + col) = w; }
        }
    }
}

__device__ __forceinline__ int row_of_pos(int b, int pos) { return (pos < CTXL) ? MLAT + b * CTXL + pos : b * SEQ + (pos - CTXL); }
template <bool SRC_BF16> __device__ __forceinline__ void tr_tile(const void* src, int stride, int col0, int myrow, float myscale, bf16_t* dst, float* wl, int lane) {
    float* scr = wl; int* rws = (int*)(wl + 64 * 65); float* scs = wl + 64 * 65 + 64;
    rws[lane] = myrow; scs[lane] = myscale;
    asm volatile("s_waitcnt lgkmcnt(0)" ::: "memory");
#pragma unroll 32
    for (int i = 0; i < 64; ++i) { const int r = rws[i]; float v;
        if (SRC_BF16) v = bf2f(((const bf16_t*)src)[(size_t)r * stride + col0 + lane]); else v = ((const float*)src)[(size_t)r * stride + col0 + lane] * scs[i];
        scr[i * 65 + lane] = v; }
    asm volatile("s_waitcnt vmcnt(0) lgkmcnt(0)" ::: "memory");
    const int pb = lane & 7, cl = lane >> 3, ib = 32 * (pb >> 2) + 16 * ((pb >> 1) & 1) + 4 * (pb & 1);
#pragma unroll
    for (int k = 0; k < 8; ++k) { const int j = cl + 8 * k; float v[8];
#pragma unroll
        for (int jj = 0; jj < 8; ++jj) v[jj] = scr[(ib + 8 * (jj >> 2) + (jj & 3)) * 65 + j];
        u32x4 w; w.x = pk2(v[0], v[1]); w.y = pk2(v[2], v[3]); w.z = pk2(v[4], v[5]); w.w = pk2(v[6], v[7]);
        *(u32x4*)(dst + (size_t)j * KVL + 8 * pb) = w; }
    asm volatile("s_waitcnt lgkmcnt(0)" ::: "memory");
}
__device__ __forceinline__ int seq_row(int b, int dir, int s);
__device__ __forceinline__ void prep_phase(const Args& a, int l, float* lds) {
    unsigned char* ws = a.ws;
    const bf16_t* P = (const bf16_t*)(ws + WS_P);
    bf16_t* Qr = (bf16_t*)(ws + WS_QR); bf16_t* Kr = (bf16_t*)(ws + WS_KR); bf16_t* Vt = (bf16_t*)(ws + WS_VT);
    float* xbc = (float*)(ws + WS_XBC); float* dtv = (float*)(ws + WS_DTV);
    const int gt = obid() * NT + otid(), GT = gridDim.x * NT;
    const float qscale = 0.125f * 1.4426950408889634f;
    for (int idx = gt; idx < MROWS * 256; idx += GT) {
        const int oct = idx & 7, hc = (idx >> 3) & 15, which = (idx >> 7) & 1, row = idx >> 8;
        const bool lat = row < MLAT; const int b = lat ? (row >> 12) : ((row - MLAT) >> 8); const int t = lat ? (row & 4095) : ((row - MLAT) & 255);
        const bf16_t* src = P + (size_t)row * NINP + (which ? KOFF : QOFF) + hc * 64;
        const u32x4 xw = *(const u32x4*)(src + oct * 8); float x[8]; unpack8(xw, x);
        float o[8];
        if (lat) {
            const u32x4 pw = *(const u32x4*)(src + (oct ^ 2) * 8); float xp[8]; unpack8(pw, xp);
            const float sign = (oct & 2) ? 1.f : -1.f; const float pos = (float)((oct & 4) ? (t & 63) : (t >> 6));
#pragma unroll
            for (int j = 0; j < 8; ++j) { const int f = (oct & 1) * 8 + j; const float inv = exp2f(-(float)f * 0.8304820237218406f); const float ang = pos * inv; float sn, cs; __sincosf(ang, &sn, &cs);
                o[j] = x[j] * cs + sign * xp[j] * sn; }
        } else {
#pragma unroll
            for (int j = 0; j < 8; ++j) o[j] = x[j];
        }
        if (!which) {
#pragma unroll
            for (int j = 0; j < 8; ++j) o[j] *= qscale;
        }
        const int pos4 = lat ? CTXL + t : t;
        bf16_t* dst = (which ? Kr : Qr) + ((size_t)(b * 16 + hc) * KVL + pos4) * 64 + oct * 8;
        u32x4 w; w.x = pk2(o[0], o[1]); w.y = pk2(o[2], o[3]); w.z = pk2(o[4], o[5]); w.w = pk2(o[6], o[7]);
        *(u32x4*)dst = w;
    }
    { const int tid_ = otid(); const int lane = tid_ & 63, wave = tid_ >> 6; float* wl = lds + wave * 4288;
      const int gw = obid() * NWAVES + wave, NGW = gridDim.x * NWAVES;
      for (int tI = gw; tI < 16 * 2 * 68; tI += NGW) { const int pt = tI % 68, rest = tI / 68, dh = rest & 1, bh = rest >> 1, b = bh >> 3, h = bh & 7;
          tr_tile<true>(P, NINP, VOFF + h * 128 + 64 * dh, row_of_pos(b, 64 * pt + lane), 1.f, Vt + ((size_t)bh * 128 + 64 * dh) * KVL + 64 * pt, wl, lane); } }
    const float* cw = a.in[13] + (size_t)l * 5 * 1536; const float* cb = a.in[14] + (size_t)l * 1536;
    for (int idx = gt; idx < MROWS * 192; idx += GT) {
        const int k8 = idx % 192, row = idx / 192, ch0 = 8 * k8;
        const bool lat = row < MLAT; const int t = lat ? (row & 4095) : ((row - MLAT) & 255); const int n = lat ? SEQ : CTXL;
        float acc[8];
        { const f32x4 b0 = *(const f32x4*)(cb + ch0), b1 = *(const f32x4*)(cb + ch0 + 4);
#pragma unroll
          for (int j = 0; j < 4; ++j) { acc[j] = b0[j]; acc[4 + j] = b1[j]; } }
#pragma unroll
        for (int j = 0; j < 5; ++j) { const int tt = t + j - 2;
            if (tt >= 0 && tt < n) { const u32x4 xw = *(const u32x4*)(P + (size_t)(row + j - 2) * NINP + XBCOFF + ch0); float x[8]; unpack8(xw, x);
                const f32x4 w0 = *(const f32x4*)(cw + j * 1536 + ch0), w1 = *(const f32x4*)(cw + j * 1536 + ch0 + 4);
#pragma unroll
                for (int q = 0; q < 4; ++q) { acc[q] += w0[q] * x[q]; acc[4 + q] += w1[q] * x[4 + q]; } } }
        f32x4 o0, o1;
#pragma unroll
        for (int q = 0; q < 4; ++q) { o0[q] = siluf_(acc[q]); o1[q] = siluf_(acc[4 + q]); }
        *(f32x4*)(xbc + (size_t)row * 1536 + ch0) = o0; *(f32x4*)(xbc + (size_t)row * 1536 + ch0 + 4) = o1;
    }
    const float* dtb = a.in[15] + l * 32; const float* alog = a.in[16] + l * 32;
    for (int idx = gt; idx < MROWS * 32; idx += GT) {
        const int i = idx & 31, row = idx >> 5;
        const float v = bf2f(P[(size_t)row * NINP + DTOFF + i]) + dtb[i];
        const float dt = fmaxf(v, 0.f) + log1pf(__expf(-fabsf(v)));
        const float av = -__expf(alog[i]);
        dtv[row * 64 + i] = dt; dtv[row * 64 + 32 + i] = __expf(dt * av);
    }
}

#define MFMA32(a, b, c) __builtin_amdgcn_mfma_f32_32x32x16_bf16((a), (b), (c), 0, 0, 0)
__device__ __forceinline__ void attn_phase(const Args& a, int l, bool with_ctx, unsigned char* lds) {
    unsigned char* ws = a.ws;
    const bf16_t* Qr = (const bf16_t*)(ws + WS_QR); const bf16_t* Kr = (const bf16_t*)(ws + WS_KR); const bf16_t* Vt = (const bf16_t*)(ws + WS_VT);
    bf16_t* yat = (bf16_t*)(ws + WS_AST) + (size_t)1 * MROWS * 1024;
    const int tid = otid(), lane = tid & 63, wid = tid >> 6, r32 = lane & 31, hi = lane >> 5, c = wid & 1, qsub = wid >> 1;
    constexpr int KT = 2 * 64 * 144, VTB = 128 * 144, BUF = KT + VTB;
    float* xch = (float*)(lds + 2 * BUF);
    const float lam_init = 0.8f - 0.6f * __expf(-0.3f * (float)l);
    float lam;
    { const float* lf = a.in[11] + l * 256; float s1 = 0.f, s2 = 0.f;
      for (int i = 0; i < 64; ++i) { s1 += lf[i] * lf[64 + i]; s2 += lf[128 + i] * lf[192 + i]; }
      lam = __expf(s1) - __expf(s2) + lam_init; }
    const float* subln = a.in[12] + l * 128;
    const int G = gridDim.x, bx = obid();
    const int vcu = (G % 8 == 0) ? (bx % 8) * (G / 8) + bx / 8 : bx;
    const int skey = tid >> 3, spart = tid & 7;
    const int nunits = with_ctx ? 544 : 512;
    for (int u0 = 2 * vcu; u0 < nunits; u0 += 2 * G) {
      for (int it = 0; it < 2; ++it) {
        const int u = u0 + it;
        int bh, qbase, nkv;
        if (u < 512) { bh = u >> 5; qbase = CTXL + 128 * (u & 31); nkv = KVL; } else { bh = (u - 512) >> 1; qbase = 128 * ((u - 512) & 1); nkv = CTXL; }
        const int b = bh >> 3, h = bh & 7;
        const bf16_t* Kg0 = Kr + ((size_t)(bh * 2) * KVL + skey) * 64 + spart * 8;
        const bf16_t* Kg1 = Kg0 + (size_t)KVL * 64;
        const bf16_t* Vg0 = Vt + ((size_t)bh * 128 + skey) * KVL + spart * 8;
        const bf16_t* Vg1 = Vg0 + (size_t)64 * KVL;
        unsigned char* kdst = lds + skey * 144 + spart * 16;
        unsigned char* vdst = lds + KT + skey * 144 + spart * 16;
        const int qpos = qbase + qsub * 32 + r32;
        bf16x8 qf[4];
        { const bf16_t* Qb = Qr + ((size_t)(bh * 2 + c) * KVL + qpos) * 64 + 8 * hi;
#pragma unroll
          for (int d0 = 0; d0 < 4; ++d0) qf[d0] = *(const bf16x8*)(Qb + 16 * d0); }
        f32x16 O[4];
#pragma unroll
        for (int j = 0; j < 4; ++j)
#pragma unroll
            for (int r = 0; r < 16; ++r) O[j][r] = 0.f;
        float negm = 0.f, lrun = 0.f; bool first = true;
        u32x4 k0 = *(const u32x4*)Kg0, k1 = *(const u32x4*)Kg1, v0 = *(const u32x4*)Vg0, v1 = *(const u32x4*)Vg1;
        __syncthreads();
        *(u32x4*)kdst = k0; *(u32x4*)(kdst + 9216) = k1; *(u32x4*)vdst = v0; *(u32x4*)(vdst + 9216) = v1;
        __syncthreads();
        const int nt = nkv >> 6;
        for (int t = 0; t < nt; ++t) {
            const int cur = t & 1;
            if (t + 1 < nt) { k0 = *(const u32x4*)(Kg0 + (size_t)(t + 1) * 64 * 64); k1 = *(const u32x4*)(Kg1 + (size_t)(t + 1) * 64 * 64);
                              v0 = *(const u32x4*)(Vg0 + (t + 1) * 64); v1 = *(const u32x4*)(Vg1 + (t + 1) * 64); }
#pragma unroll
            for (int sub = 0; sub < 2; ++sub) {
                const unsigned char* kb = lds + cur * BUF + c * 9216 + (32 * sub + r32) * 144 + hi * 16;
                const unsigned char* vb = lds + cur * BUF + KT + r32 * 144 + 64 * sub + hi * 16;
                bf16x8 kf[4], vf[8];
#pragma unroll
                for (int d0 = 0; d0 < 4; ++d0) kf[d0] = *(const bf16x8*)(kb + d0 * 32);
#pragma unroll
                for (int j = 0; j < 4; ++j) { vf[2 * j] = *(const bf16x8*)(vb + j * 32 * 144); vf[2 * j + 1] = *(const bf16x8*)(vb + j * 32 * 144 + 32); }
                __builtin_amdgcn_sched_barrier(0);
                f32x16 S;
#pragma unroll
                for (int r = 0; r < 16; ++r) S[r] = negm;
#pragma unroll
                for (int d0 = 0; d0 < 4; ++d0) S = MFMA32(kf[d0], qf[d0], S);
                float mx = S[0];
#pragma unroll
                for (int r = 1; r < 16; ++r) mx = fmaxf(mx, S[r]);
                if (first || __any(mx > 8.f)) {
                    mx = fmaxf(mx, __shfl_xor(mx, 32));
                    const float dl = first ? mx : fmaxf(mx, 0.f); const float alpha = first ? 1.f : __builtin_amdgcn_exp2f(-dl); negm -= dl; lrun *= alpha; first = false;
#pragma unroll
                    for (int r = 0; r < 16; ++r) S[r] -= dl;
#pragma unroll
                    for (int j = 0; j < 4; ++j)
#pragma unroll
                        for (int r = 0; r < 16; ++r) O[j][r] *= alpha;
                }
                float ps = 0.f;
#pragma unroll
                for (int r = 0; r < 16; ++r) { S[r] = __builtin_amdgcn_exp2f(S[r]); ps += S[r]; }
                lrun += ps;
                u32x4 p0, p1;
                p0.x = pk2(S[0], S[1]); p0.y = pk2(S[2], S[3]); p0.z = pk2(S[4], S[5]); p0.w = pk2(S[6], S[7]);
                p1.x = pk2(S[8], S[9]); p1.y = pk2(S[10], S[11]); p1.z = pk2(S[12], S[13]); p1.w = pk2(S[14], S[15]);
                const bf16x8 pa0 = __builtin_bit_cast(bf16x8, p0), pa1 = __builtin_bit_cast(bf16x8, p1);
#pragma unroll
                for (int j = 0; j < 4; ++j) O[j] = MFMA32(vf[2 * j], pa0, O[j]);
#pragma unroll
                for (int j = 0; j < 4; ++j) O[j] = MFMA32(vf[2 * j + 1], pa1, O[j]);
            }
            if (t + 1 < nt) { unsigned char* kd = kdst + (cur ^ 1) * BUF; unsigned char* vd = vdst + (cur ^ 1) * BUF;
                *(u32x4*)kd = k0; *(u32x4*)(kd + 9216) = k1; *(u32x4*)vd = v0; *(u32x4*)(vd + 9216) = v1; }
            __syncthreads();
        }
        const float ltot = lrun + __shfl_xor(lrun, 32); const float inv = 1.f / ltot;
        float* xp = xch + qsub * 4096 + lane;
        if (c == 1) { const float li = lam * inv;
#pragma unroll
            for (int j = 0; j < 4; ++j)
#pragma unroll
                for (int r = 0; r < 16; ++r) xp[(j * 16 + r) * 64] = li * O[j][r]; }
        __syncthreads();
        if (c == 0) {
            float ss = 0.f;
#pragma unroll
            for (int j = 0; j < 4; ++j)
#pragma unroll
                for (int r = 0; r < 16; ++r) { const float v = O[j][r] * inv - xp[(j * 16 + r) * 64]; O[j][r] = v; ss += v * v; }
            ss += __shfl_xor(ss, 32);
            const float sc = rsqrtf(ss * (1.f / 128.f) + EPS) * (1.f - lam_init);
            const int row = row_of_pos(b, qpos);
            bf16_t* orow = yat + (size_t)row * 1024 + h * 128;
#pragma unroll
            for (int j = 0; j < 4; ++j)
#pragma unroll
                for (int rq = 0; rq < 4; ++rq) { const int dv = 32 * j + 8 * rq + 4 * hi; const f32x4 g = *(const f32x4*)(subln + dv);
                    u32x2 w; w.x = pk2(O[j][4 * rq] * sc * g[0], O[j][4 * rq + 1] * sc * g[1]); w.y = pk2(O[j][4 * rq + 2] * sc * g[2], O[j][4 * rq + 3] * sc * g[3]);
                    *(u32x2*)(orow + dv) = w; }
        }
      }
    }
}

__device__ __forceinline__ int seq_row(int b, int dir, int s) {
    if (s < CTXL) return MLAT + b * CTXL + (dir ? (CTXL - 1 - s) : s);
    const int t = s - CTXL; return b * SEQ + (dir ? (SEQ - 1 - t) : t);
}
__device__ __forceinline__ void la_phase(const Args& a, int l) {
    unsigned char* ws = a.ws;
    const bf16_t* P = (const bf16_t*)(ws + WS_P); float* LA = (float*)(ws + WS_LA);
    const float* dtb = a.in[15] + l * 32; const float* alog = a.in[16] + l * 32;
    const int tid = otid(), lane = tid & 63, wave = tid >> 6;
    const int gw = obid() * NWAVES + wave, NGW = gridDim.x * NWAVES;
    for (int u = gw; u < 64 * NCH; u += NGW) {
        const int combo = u % 64, ch = u / 64, head = combo & 15, dir = (combo >> 4) & 1, b = combo >> 5;
        const int i = dir * 16 + head; const float av = -__expf(alog[i]), bias = dtb[i];
        float v[4]; float run = 0.f;
#pragma unroll
        for (int k = 0; k < 4; ++k) { const int sp = ch * 256 + lane * 4 + k; const int row = seq_row(b, dir, sp);
            const float x = bf2f(P[(size_t)row * NINP + DTOFF + i]) + bias; const float dt = fmaxf(x, 0.f) + log1pf(__expf(-fabsf(x)));
            run += dt * av; v[k] = run; }
        float incl = run;
#pragma unroll
        for (int o = 1; o < 64; o <<= 1) { const float t = __shfl_up(incl, o); if (lane >= o) incl += t; }
        const float excl = incl - run;
        *(f32x4*)(LA + (size_t)combo * KVL + ch * 256 + lane * 4) = (f32x4){v[0] + excl, v[1] + excl, v[2] + excl, v[3] + excl};
    }
}
__device__ __forceinline__ void prep2_phase(const Args& a, float* lds) {
    unsigned char* ws = a.ws;
    const float* xbc = (const float*)(ws + WS_XBC); const float* dtv = (const float*)(ws + WS_DTV);
    bf16_t* XDT = (bf16_t*)(ws + WS_XDT); bf16_t* BT = (bf16_t*)(ws + WS_BT); bf16_t* BN = (bf16_t*)(ws + WS_BN); bf16_t* CN = (bf16_t*)(ws + WS_CN);
    const int gt = obid() * NT + otid(), GT = gridDim.x * NT;
    { const int tid_ = otid(); const int lane = tid_ & 63, wave = tid_ >> 6; float* wl = lds + wave * 4288;
      const int gw = obid() * NWAVES + wave, NGW = gridDim.x * NWAVES;
      for (int tI = gw; tI < 4 * 16 * 68 + 8 * 2 * 68; tI += NGW) {
          if (tI < 4 * 16 * 68) { const int pt = tI % 68, rest = tI / 68, head = rest & 15, bd = rest >> 4, b = bd >> 1, dir = bd & 1;
              const int row = seq_row(b, dir, 64 * pt + lane);
              tr_tile<false>(xbc, 1536, head * 64, row, dtv[row * 64 + dir * 16 + head], XDT + ((size_t)bd * 1024 + head * 64) * KVL + 64 * pt, wl, lane);
          } else { const int t2 = tI - 4 * 16 * 68; const int pt = t2 % 68, rest = t2 / 68, nh = rest & 1, bdg = rest >> 1, g = bdg & 1, dir = (bdg >> 1) & 1, b = bdg >> 2;
              tr_tile<false>(xbc, 1536, 1024 + g * 128 + 64 * nh, seq_row(b, dir, 64 * pt + lane), 1.f, BT + ((size_t)bdg * 128 + 64 * nh) * KVL + 64 * pt, wl, lane); }
      } }
    for (int idx = gt; idx < 8 * KVL * 16; idx += GT) {
        const int oct = idx & 15, rest = idx >> 4, sp = rest % KVL, bdg = rest / KVL, g = bdg & 1, dir = (bdg >> 1) & 1, b = bdg >> 2;
        const int row = seq_row(b, dir, sp);
        const float* src = xbc + (size_t)row * 1536 + 1024 + g * 128 + oct * 8;
        const f32x4 b0 = *(const f32x4*)src, b1 = *(const f32x4*)(src + 4), c0 = *(const f32x4*)(src + 256), c1 = *(const f32x4*)(src + 260);
        u32x4 w; w.x = pk2(b0[0], b0[1]); w.y = pk2(b0[2], b0[3]); w.z = pk2(b1[0], b1[1]); w.w = pk2(b1[2], b1[3]);
        *(u32x4*)(BN + ((size_t)bdg * KVL + sp) * 128 + oct * 8) = w;
        w.x = pk2(c0[0], c0[1]); w.y = pk2(c0[2], c0[3]); w.z = pk2(c1[0], c1[1]); w.w = pk2(c1[2], c1[3]);
        *(u32x4*)(CN + ((size_t)bdg * KVL + sp) * 128 + oct * 8) = w;
    }
}
__device__ __forceinline__ void ssd_state_phase(const Args& a, float* lds) {
    unsigned char* ws = a.ws;
    const bf16_t* XDT = (const bf16_t*)(ws + WS_XDT); const bf16_t* BT = (const bf16_t*)(ws + WS_BT); const float* LA = (const float*)(ws + WS_LA);
    bf16_t* HINB = (bf16_t*)(ws + WS_HINB);
    const int tid = otid(), lane = tid & 63, wid = tid >> 6, r32 = lane & 31, hi = lane >> 5, pb = wid & 1, nb = wid >> 1;
    const int sblk0 = ((int)gridDim.x >= 128) ? (int)gridDim.x - 64 : 0;
    for (int combo = obid() - sblk0; combo < 64; combo += (int)gridDim.x - sblk0) {
        if (combo < 0) break;
        const int head = combo & 15, bd = combo >> 4, g = head >> 3;
        const bf16_t* xa = XDT + ((size_t)bd * 1024 + head * 64 + 32 * pb + r32) * KVL + 8 * hi;
        const bf16_t* bb = BT + ((size_t)(bd * 2 + g) * 128 + 32 * nb + r32) * KVL + 8 * hi;
        f32x16 Hs;
#pragma unroll
        for (int r = 0; r < 16; ++r) Hs[r] = 0.f;
        for (int c = 0; c < NCH; ++c) {
            bf16_t* hout = HINB + ((size_t)(combo * NCH + c)) * 8192 + 32 * nb + r32;
#pragma unroll
            for (int r = 0; r < 16; ++r) { const int p = 32 * pb + (r & 3) + 8 * (r >> 2) + 4 * hi; hout[p * 128] = (bf16_t)(pk2(Hs[r], 0.f) & 0xffffu); }
            if (c == NCH - 1) break;
            const float* lac = LA + (size_t)combo * KVL + c * 256;
            const float lalast = lac[255];
            __syncthreads();
            if (tid < 256) { const int tok = (tid & ~12) | ((tid & 4) << 1) | ((tid & 8) >> 1); lds[tid] = __expf(lalast - lac[tok]); }
            __syncthreads();
            f32x16 S;
#pragma unroll
            for (int r = 0; r < 16; ++r) S[r] = 0.f;
#pragma unroll
            for (int k = 0; k < 16; ++k) {
                const u32x4 xw = *(const u32x4*)(xa + c * 256 + 16 * k); const bf16x8 bf = *(const bf16x8*)(bb + c * 256 + 16 * k);
                float xv[8]; unpack8(xw, xv);
                const f32x4 w0 = *(const f32x4*)(lds + 16 * k + 8 * hi), w1 = *(const f32x4*)(lds + 16 * k + 8 * hi + 4);
                u32x4 sw; sw.x = pk2(xv[0] * w0[0], xv[1] * w0[1]); sw.y = pk2(xv[2] * w0[2], xv[3] * w0[3]); sw.z = pk2(xv[4] * w1[0], xv[5] * w1[1]); sw.w = pk2(xv[6] * w1[2], xv[7] * w1[3]);
                S = MFMA32(__builtin_bit_cast(bf16x8, sw), bf, S);
            }
            const float dec = __expf(lalast);
#pragma unroll
            for (int r = 0; r < 16; ++r) Hs[r] = Hs[r] * dec + S[r];
        }
    }
}
__device__ __forceinline__ void ssd_out_phase(const Args& a, unsigned char* lds, int ch_lo) {
    unsigned char* ws = a.ws;
    const bf16_t* XDT = (const bf16_t*)(ws + WS_XDT); const bf16_t* BN = (const bf16_t*)(ws + WS_BN); const bf16_t* CN = (const bf16_t*)(ws + WS_CN);
    const bf16_t* HINB = (const bf16_t*)(ws + WS_HINB); const float* LA = (const float*)(ws + WS_LA); bf16_t* yssd = (bf16_t*)(ws + WS_YSSD);
    const int tid = otid(), lane = tid & 63, w = tid >> 6, r32 = lane & 31, hi = lane >> 5;
    constexpr int BNS = 0, XTS = 256 * 272, HNS = XTS + 64 * 528, LAS_ = HNS + 64 * 272;
    const float* la_s = (const float*)(lds + LAS_);
    const int nunits = 64 * (NCH - ch_lo);
    for (int u = obid(); u < nunits; u += gridDim.x) {
        const int combo = u % 64, c = ch_lo + u / 64;
        const int head = combo & 15, bd = combo >> 4, dir = bd & 1, b = bd >> 1, g = head >> 3;
        u32x4 sb[8], sx[4], sh[2];
        { const bf16_t* src = BN + ((size_t)(bd * 2 + g) * KVL + c * 256) * 128;
#pragma unroll
          for (int it = 0; it < 8; ++it) { const int q = tid + NT * it; sb[it] = *(const u32x4*)(src + (size_t)(q >> 4) * 128 + (q & 15) * 8); } }
        { const bf16_t* src = XDT + ((size_t)bd * 1024 + head * 64) * KVL + c * 256;
#pragma unroll
          for (int it = 0; it < 4; ++it) { const int q = tid + NT * it; sx[it] = *(const u32x4*)(src + (size_t)(q >> 5) * KVL + (q & 31) * 8); } }
        { const bf16_t* src = HINB + ((size_t)(combo * NCH + c)) * 8192;
#pragma unroll
          for (int it = 0; it < 2; ++it) { const int q = tid + NT * it; sh[it] = *(const u32x4*)(src + (size_t)q * 8); } }
        const float lav = (tid < 256) ? LA[(size_t)combo * KVL + c * 256 + tid] : 0.f;
        const int qi = 32 * w + r32;
        bf16x8 qf[8];
        { const bf16_t* cq = CN + ((size_t)(bd * 2 + g) * KVL + c * 256 + qi) * 128 + 8 * hi;
#pragma unroll
          for (int kn = 0; kn < 8; ++kn) qf[kn] = *(const bf16x8*)(cq + 16 * kn); }
        __syncthreads();
#pragma unroll
        for (int it = 0; it < 8; ++it) { const int q = tid + NT * it; *(u32x4*)(lds + BNS + (q >> 4) * 272 + (q & 15) * 16) = sb[it]; }
#pragma unroll
        for (int it = 0; it < 4; ++it) { const int q = tid + NT * it; *(u32x4*)(lds + XTS + (q >> 5) * 528 + (q & 31) * 16) = sx[it]; }
#pragma unroll
        for (int it = 0; it < 2; ++it) { const int q = tid + NT * it; *(u32x4*)(lds + HNS + (q >> 4) * 272 + (q & 15) * 16) = sh[it]; }
        if (tid < 256) ((float*)(lds + LAS_))[tid] = lav;
        __syncthreads();
        const float lai = la_s[qi];
        f32x16 Oo[2], O[2];
#pragma unroll
        for (int pb = 0; pb < 2; ++pb)
#pragma unroll
            for (int r = 0; r < 16; ++r) { Oo[pb][r] = 0.f; O[pb][r] = 0.f; }
#pragma unroll
        for (int pb = 0; pb < 2; ++pb)
#pragma unroll
            for (int kn = 0; kn < 8; ++kn) { const bf16x8 hf = *(const bf16x8*)(lds + HNS + (32 * pb + r32) * 272 + 32 * kn + 16 * hi); Oo[pb] = MFMA32(hf, qf[kn], Oo[pb]); }
        for (int jb = 0; jb <= w; ++jb) {
            bf16x8 kf[8], vf[4];
#pragma unroll
            for (int kn = 0; kn < 8; ++kn) kf[kn] = *(const bf16x8*)(lds + BNS + (32 * jb + r32) * 272 + 32 * kn + 16 * hi);
#pragma unroll
            for (int pb = 0; pb < 2; ++pb) { vf[2 * pb] = *(const bf16x8*)(lds + XTS + (32 * pb + r32) * 528 + 64 * jb + 16 * hi); vf[2 * pb + 1] = *(const bf16x8*)(lds + XTS + (32 * pb + r32) * 528 + 64 * jb + 32 + 16 * hi); }
            f32x16 S;
#pragma unroll
            for (int r = 0; r < 16; ++r) S[r] = 0.f;
#pragma unroll
            for (int kn = 0; kn < 8; ++kn) S = MFMA32(kf[kn], qf[kn], S);
#pragma unroll
            for (int q = 0; q < 4; ++q) { const f32x4 lj = *(const f32x4*)(la_s + 32 * jb + 8 * q + 4 * hi);
#pragma unroll
                for (int e = 0; e < 4; ++e) { const int j = 32 * jb + 8 * q + 4 * hi + e; const float wgt = (j <= qi) ? __expf(fminf(lai - lj[e], 0.f)) : 0.f; S[4 * q + e] *= wgt; } }
            u32x4 p0, p1;
            p0.x = pk2(S[0], S[1]); p0.y = pk2(S[2], S[3]); p0.z = pk2(S[4], S[5]); p0.w = pk2(S[6], S[7]);
            p1.x = pk2(S[8], S[9]); p1.y = pk2(S[10], S[11]); p1.z = pk2(S[12], S[13]); p1.w = pk2(S[14], S[15]);
            const bf16x8 pa0 = __builtin_bit_cast(bf16x8, p0), pa1 = __builtin_bit_cast(bf16x8, p1);
#pragma unroll
            for (int pb = 0; pb < 2; ++pb) { O[pb] = MFMA32(vf[2 * pb], pa0, O[pb]); O[pb] = MFMA32(vf[2 * pb + 1], pa1, O[pb]); }
        }
        const float ei = __expf(lai);
        const int row = seq_row(b, dir, c * 256 + qi);
        bf16_t* yo = yssd + ((size_t)dir * MROWS + row) * 1024 + head * 64;
#pragma unroll
        for (int pb = 0; pb < 2; ++pb)
#pragma unroll
            for (int q = 0; q < 4; ++q) { f32x4 o;
#pragma unroll
                for (int e = 0; e < 4; ++e) o[e] = O[pb][4 * q + e] + ei * Oo[pb][4 * q + e];
                u32x2 w2; w2.x = pk2(o[0], o[1]); w2.y = pk2(o[2], o[3]); *(u32x2*)(yo + 32 * pb + 8 * q + 4 * hi) = w2; }
    }
}

__device__ __forceinline__ void s5_phase(const Args& a, int l, unsigned char* ldsb) {
    unsigned char* ws = a.ws;
    const bf16_t* P = (const bf16_t*)(ws + WS_P); bf16_t* ys5 = (bf16_t*)(ws + WS_YS5);
    const int tid = otid(), lane = tid & 63, w = tid >> 6, r32 = lane & 31, hi = lane >> 5;
    f32x2v* Eseg = (f32x2v*)ldsb;
    unsigned char* hb = ldsb + 16384 + w * 8704;
    const int hh = (r32 >> 2) & 1, rr = (r32 & 3) + 4 * (r32 >> 3), tl = 16 * hh + rr;
    const int mysg = 2 * w + hi;
    for (int u = obid(); u < 256; u += gridDim.x) {
        const int g = u & 63, dir = (u >> 6) & 1, b = u >> 7;
        float lbr[2], lbi[2], l16r[2], l16i[2]; bf16x8 bre[2], bim[2];
#pragma unroll
        for (int pbk = 0; pbk < 2; ++pbk) {
            const int p = 32 * pbk + r32;
            const size_t li = ((size_t)(l * 2 + dir) * 64 + g) * 64 + p;
            const float lre = a.in[19][li], lim = a.in[20][li];
            const float delta = __expf(a.in[21][(l * 2 + dir) * 64 + g]);
            const float er = __expf(lre * delta); float sn, cs; __sincosf(lim * delta, &sn, &cs);
            const float xr = er * cs, xi = er * sn; lbr[pbk] = xr; lbi[pbk] = xi;
            const float den = 1.f / (lre * lre + lim * lim);
            const float cr = ((xr - 1.f) * lre + xi * lim) * den, ci = (xi * lre - (xr - 1.f) * lim) * den;
            const float* bre_g = a.in[22] + (((size_t)l * 64 + g) * 64 + p) * 16 + 8 * hi; const float* bim_g = a.in[23] + (((size_t)l * 64 + g) * 64 + p) * 16 + 8 * hi;
            float fr[8], fi[8];
#pragma unroll
            for (int j = 0; j < 8; ++j) { const float x = bre_g[j], y = bim_g[j]; fr[j] = cr * x - ci * y; fi[j] = cr * y + ci * x; }
            u32x4 t; t.x = pk2(fr[0], fr[1]); t.y = pk2(fr[2], fr[3]); t.z = pk2(fr[4], fr[5]); t.w = pk2(fr[6], fr[7]); bre[pbk] = __builtin_bit_cast(bf16x8, t);
            t.x = pk2(fi[0], fi[1]); t.y = pk2(fi[2], fi[3]); t.z = pk2(fi[4], fi[5]); t.w = pk2(fi[6], fi[7]); bim[pbk] = __builtin_bit_cast(bf16x8, t);
            float pr_ = xr, pi_ = xi;
#pragma unroll
            for (int k = 0; k < 4; ++k) { const float nr = pr_ * pr_ - pi_ * pi_, ni = 2.f * pr_ * pi_; pr_ = nr; pi_ = ni; }
            l16r[pbk] = pr_; l16i[pbk] = pi_;
        }
        bf16x8 cA[8];
#pragma unroll
        for (int kk = 0; kk < 8; ++kk) {
            u32x4 t = (u32x4){0u, 0u, 0u, 0u};
            if (r32 < 16) { const size_t ci_ = (((size_t)l * 64 + g) * 16 + r32) * 64 + 8 * kk + 4 * hi;
                const f32x4 c4 = *(const f32x4*)(a.in[24] + ci_), d4 = *(const f32x4*)(a.in[25] + ci_);
                t.x = pk2(c4[0], -d4[0]); t.y = pk2(c4[1], -d4[1]); t.z = pk2(c4[2], -d4[2]); t.w = pk2(c4[3], -d4[3]); }
            cA[kk] = __builtin_bit_cast(bf16x8, t);
        }
        float Hcr[2] = {0.f, 0.f}, Hci[2] = {0.f, 0.f};
        u32x4 unext = *(const u32x4*)(P + (size_t)seq_row(b, dir, 32 * w + tl) * NINP + UOFF + g * 16 + 8 * hi);
        for (int tile = 0; tile < NCH; ++tile) {
            const u32x4 ucur = unext;
            if (tile + 1 < NCH) unext = *(const u32x4*)(P + (size_t)seq_row(b, dir, (tile + 1) * 256 + 32 * w + tl) * NINP + UOFF + g * 16 + 8 * hi);
            const bf16x8 uA = __builtin_bit_cast(bf16x8, ucur);
            f32x16 Dre[2], Dim[2]; f32x16 zero;
#pragma unroll
            for (int r = 0; r < 16; ++r) zero[r] = 0.f;
            f32x2v* Ew = Eseg + (tile & 1) * 1024;
#pragma unroll
            for (int pbk = 0; pbk < 2; ++pbk) {
                Dre[pbk] = MFMA32(uA, bre[pbk], zero); Dim[pbk] = MFMA32(uA, bim[pbk], zero);
                float hr = 0.f, hi_ = 0.f;
#pragma unroll
                for (int r = 0; r < 16; ++r) { const float nr = lbr[pbk] * hr - lbi[pbk] * hi_ + Dre[pbk][r], ni = lbr[pbk] * hi_ + lbi[pbk] * hr + Dim[pbk][r];
                    hr = nr; hi_ = ni; Dre[pbk][r] = hr; Dim[pbk][r] = hi_; }
                Ew[mysg * 64 + 32 * pbk + r32] = (f32x2v){hr, hi_};
            }
            __syncthreads();
#pragma unroll
            for (int pbk = 0; pbk < 2; ++pbk) {
                float cr_ = Hcr[pbk], ci2 = Hci[pbk], inr = 0.f, ini = 0.f;
#pragma unroll
                for (int sg = 0; sg < 16; ++sg) {
                    if (sg == mysg) { inr = cr_; ini = ci2; }
                    const f32x2v e = Ew[sg * 64 + 32 * pbk + r32];
                    const float nr = l16r[pbk] * cr_ - l16i[pbk] * ci2 + e.x, ni = l16r[pbk] * ci2 + l16i[pbk] * cr_ + e.y;
                    cr_ = nr; ci2 = ni;
                }
                Hcr[pbk] = cr_; Hci[pbk] = ci2;
#pragma unroll
                for (int r = 0; r < 16; ++r) { const float nr = lbr[pbk] * inr - lbi[pbk] * ini, ni = lbr[pbk] * ini + lbi[pbk] * inr; inr = nr; ini = ni;
                    *(unsigned*)(hb + (16 * hi + r) * 272 + 4 * (32 * pbk + r32)) = pk2(Dre[pbk][r] + inr, Dim[pbk][r] + ini); }
            }
            asm volatile("s_waitcnt lgkmcnt(0)" ::: "memory");
            f32x16 Y = zero;
#pragma unroll
            for (int kk = 0; kk < 8; ++kk) { const bf16x8 hB = *(const bf16x8*)(hb + r32 * 272 + 32 * kk + 16 * hi); Y = MFMA32(cA[kk], hB, Y); }
            const int row = seq_row(b, dir, tile * 256 + 32 * w + r32);
            bf16_t* yo = ys5 + ((size_t)dir * MROWS + row) * 1024 + g * 16 + 4 * hi;
            { u32x2 w2; w2.x = pk2(Y[0], Y[1]); w2.y = pk2(Y[2], Y[3]); *(u32x2*)yo = w2; w2.x = pk2(Y[4], Y[5]); w2.y = pk2(Y[6], Y[7]); *(u32x2*)(yo + 8) = w2; }
            asm volatile("s_waitcnt lgkmcnt(0)" ::: "memory");
        }
        __syncthreads();
    }
}

__device__ __forceinline__ float gelu_tanh(float x) { const float t = 0.7978845608028654f * (x + 0.044715f * x * x * x); const float e = __expf(2.f * t); const float th = 1.f - 2.f / (e + 1.f); return 0.5f * x * (1.f + th); }
__device__ __forceinline__ void post_phase(const Args& a, int l, int nrows) {
    unsigned char* ws = a.ws;
    const bf16_t* P = (const bf16_t*)(ws + WS_P); const float* xbc = (const float*)(ws + WS_XBC);
    const bf16_t* yssd = (const bf16_t*)(ws + WS_YSSD); const bf16_t* ys5 = (const bf16_t*)(ws + WS_YS5);
    bf16_t* s5g = (bf16_t*)(ws + WS_AST); bf16_t* yss = (bf16_t*)(ws + WS_AST) + (size_t)2 * MROWS * 1024;
    const float* dssd = a.in[17] + l * 16; const float* gn = a.in[18] + l * 1024; const float* ds5 = a.in[26] + l * 1024;
    const int tid = otid(), lane = tid & 63, wave = tid >> 6;
    const int gw = obid() * NWAVES + wave, NGW = gridDim.x * NWAVES;
    for (int row = gw; row < nrows; row += NGW) {
        float v[2][8]; float ss = 0.f;
#pragma unroll
        for (int k = 0; k < 2; ++k) { const int ch = 8 * lane + 512 * k; const float dd = dssd[ch >> 6];
            const u32x4 zw = *(const u32x4*)(P + (size_t)row * NINP + ZOFF + ch); float z[8]; unpack8(zw, z);
            float yf[8], yb[8]; unpack8(*(const u32x4*)(yssd + (size_t)row * 1024 + ch), yf); unpack8(*(const u32x4*)(yssd + ((size_t)MROWS + row) * 1024 + ch), yb);
#pragma unroll
            for (int q = 0; q < 2; ++q) { const f32x4 xv = *(const f32x4*)(xbc + (size_t)row * 1536 + ch + 4 * q);
#pragma unroll
                for (int j = 0; j < 4; ++j) { const float y = (yf[4 * q + j] + yb[4 * q + j] + dd * xv[j]) * siluf_(z[4 * q + j]); v[k][4 * q + j] = y; ss += y * y; } } }
        const float rstd = rsqrtf(wave_sum(ss) * (1.f / 1024.f) + EPS);
#pragma unroll
        for (int k = 0; k < 2; ++k) { const int ch = 8 * lane + 512 * k; const f32x4 g0 = *(const f32x4*)(gn + ch), g1 = *(const f32x4*)(gn + ch + 4);
            u32x4 w; w.x = pk2(v[k][0] * rstd * g0[0], v[k][1] * rstd * g0[1]); w.y = pk2(v[k][2] * rstd * g0[2], v[k][3] * rstd * g0[3]);
            w.z = pk2(v[k][4] * rstd * g1[0], v[k][5] * rstd * g1[1]); w.w = pk2(v[k][6] * rstd * g1[2], v[k][7] * rstd * g1[3]);
            *(u32x4*)(yss + (size_t)row * 1024 + ch) = w; }
#pragma unroll
        for (int k = 0; k < 2; ++k) { const int ch = 8 * lane + 512 * k;
            const u32x4 uw = *(const u32x4*)(P + (size_t)row * NINP + UOFF + ch); float uu[8]; unpack8(uw, uu); float o[8];
            float yf[8], yb[8]; unpack8(*(const u32x4*)(ys5 + (size_t)row * 1024 + ch), yf); unpack8(*(const u32x4*)(ys5 + ((size_t)MROWS + row) * 1024 + ch), yb);
#pragma unroll
            for (int q = 0; q < 2; ++q) { const f32x4 dv = *(const f32x4*)(ds5 + ch + 4 * q);
#pragma unroll
                for (int j = 0; j < 4; ++j) o[4 * q + j] = gelu_tanh(yf[4 * q + j] + yb[4 * q + j] + dv[j] * uu[4 * q + j]); }
            u32x4 w; w.x = pk2(o[0], o[1]); w.y = pk2(o[2], o[3]); w.z = pk2(o[4], o[5]); w.w = pk2(o[6], o[7]);
            *(u32x4*)(s5g + (size_t)row * 1024 + ch) = w; }
    }
}

#define LAS __attribute__((address_space(3)))
#define XB_TMO      128
#define XB_XCNT(j)  (256  + 64 * (j))
#define XB_XSUB(j)  (1280 + 64 * (j))
#define XB_XGEN(j)  (2304 + 64 * (j))
#define XB_TOP      3328
#define XB_TOPGEN   3392
#define XCD_BAR_WORDS 3456
#define XB_SPIN_CAP (1u << 20)
__device__ __forceinline__ unsigned xb_ld(unsigned* p)              { return __hip_atomic_load(p, __ATOMIC_RELAXED, __HIP_MEMORY_SCOPE_AGENT); }
__device__ __forceinline__ unsigned xb_add(unsigned* p, unsigned v) { return __hip_atomic_fetch_add(p, v, __ATOMIC_RELAXED, __HIP_MEMORY_SCOPE_AGENT); }
__device__ __forceinline__ unsigned xb_xcc_id() { return (unsigned)__builtin_amdgcn_s_getreg((3 << 11) | 20) & 0xFu; }
#define XB_SPIN(cond, bar) do { unsigned _sp = 0; while (cond) { __builtin_amdgcn_s_sleep(1); \
    if ((++_sp & 255u) == 0u) { if (xb_ld(&(bar)[XB_TMO])) break; if (_sp > XB_SPIN_CAP) { atomicAdd(&(bar)[XB_TMO], 1u); break; } } } } while (0)
struct XcdBarrier { unsigned* bar; unsigned x; volatile LAS unsigned* st; };
__device__ __forceinline__ XcdBarrier xcd_barrier_post(unsigned* bar, volatile LAS unsigned* st) {
    XcdBarrier b; b.bar = bar; b.x = xb_xcc_id(); b.st = st;
    if (threadIdx.x == 0) (void)xb_add(&bar[XB_XCNT(b.x)], 1u);
    return b;
}
__device__ __forceinline__ void xcd_barrier_complete(unsigned* bar, unsigned x, unsigned& nloc, unsigned& nx) {
    const unsigned G = gridDim.x * gridDim.y * gridDim.z;
    unsigned sum, cnt, mine, sp = 0u;
    for (;;) {
        sum = 0u; cnt = 0u; mine = 0u;
#pragma unroll
        for (unsigned j = 0; j < 16; ++j) { const unsigned c = xb_ld(&bar[XB_XCNT(j)]); sum += c; cnt += (c > 0u) ? 1u : 0u; mine = (j == x) ? c : mine; }
        if (sum == G) break;
        __builtin_amdgcn_s_sleep(1);
        if ((++sp & 255u) == 0u) { if (xb_ld(&bar[XB_TMO])) break; if (sp > XB_SPIN_CAP) { atomicAdd(&bar[XB_TMO], 1u); break; } }
    }
    nloc = mine > 0u ? mine : 1u; nx = cnt > 0u ? cnt : 1u;
}
__device__ __forceinline__ void xcd_barrier(const XcdBarrier& b) {
    asm volatile("s_waitcnt vmcnt(0)" ::: "memory");
    __syncthreads();
    if (threadIdx.x == 0) {
        unsigned* bar = b.bar;
        __builtin_amdgcn_s_waitcnt(0);
        unsigned nloc = b.st[0], nx = b.st[1];
        if (nloc == 0u) { xcd_barrier_complete(bar, b.x, nloc, nx); b.st[0] = nloc; b.st[1] = nx; }
        const unsigned old = xb_add(&bar[XB_XSUB(b.x)], 1u);
        const unsigned gen = old / nloc;
        if (old + 1u == (gen + 1u) * nloc) {
            __builtin_amdgcn_fence(__ATOMIC_RELEASE, "agent");
            asm volatile("s_waitcnt vmcnt(0)" ::: "memory");
            const unsigned og = xb_add(&bar[XB_TOP], 1u);
            const unsigned tg = og / nx;
            if (og + 1u == (tg + 1u) * nx) xb_add(&bar[XB_TOPGEN], 1u);
            else XB_SPIN(xb_ld(&bar[XB_TOPGEN]) == tg, bar);
            __builtin_amdgcn_fence(__ATOMIC_ACQUIRE, "agent");
            xb_add(&bar[XB_XGEN(b.x)], 1u);
            asm volatile("s_waitcnt vmcnt(0)" ::: "memory");
        } else {
            XB_SPIN(xb_ld(&bar[XB_XGEN(b.x)]) == gen, bar);
            __builtin_amdgcn_fence(__ATOMIC_ACQUIRE, "agent");
            asm volatile("s_waitcnt vmcnt(0)" ::: "memory");
        }
    }
    __syncthreads();
}

__global__ void __launch_bounds__(NT, 2) mega(Args a) {
    extern __shared__ __attribute__((aligned(16))) unsigned char lds[];
    cg::grid_group grid = cg::this_grid();
    PG8_LAS unsigned char* glds = (PG8_LAS unsigned char*)lds;
    float* fl = (float*)lds;
    unsigned char* ws = a.ws;
    float* modv = (float*)(ws + WS_MOD);
    float* xc = (float*)(ws + WS_XC);
    bf16_t* H = (bf16_t*)(ws + WS_H); bf16_t* P = (bf16_t*)(ws + WS_P); bf16_t* HFF = (bf16_t*)(ws + WS_P);
    bf16_t* AST = (bf16_t*)(ws + WS_AST);
    bf16_t* BR0 = (bf16_t*)(ws + WS_BR0); bf16_t* BR1 = (bf16_t*)(ws + WS_BR1); bf16_t* MRG = (bf16_t*)(ws + WS_MRG);
    bf16_t* OBH = (bf16_t*)(ws + WS_O);
    const int G = gridDim.x, bx = obid();
    volatile LAS unsigned* bst = (volatile LAS unsigned*)((LAS unsigned char*)lds + (LDS_BYTES - 16));
    if (threadIdx.x == 0) { bst[0] = 0u; bst[1] = 0u; }
    __syncthreads();
    (void)xcd_barrier_post((unsigned*)(ws + WS_BAR), bst);
#define GSYNC() do { XcdBarrier xb_; xb_.bar = (unsigned*)(a.ws + WS_BAR); xb_.x = xb_xcc_id(); xb_.st = (volatile LAS unsigned*)((LAS unsigned char*)lds + (LDS_BYTES - 16)); xcd_barrier(xb_); } while (0)

    mod_phase(a, fl, modv, 0, 128, G);
    __syncthreads();
    wconv_phase(a, 0, fl, 1, 0);
    if (a.ws == nullptr) grid.sync();
    GSYNC();
    if (PROBE_DUP == 9) { for (int i = 0; i < 20; ++i) GSYNC(); }
    { RowPass rp{}; rp.src_lat = a.in[0]; rp.src_ctx = a.in[2]; rp.dst_lat = nullptr; rp.dst_ctx = nullptr; rp.o = nullptr;
      rp.h = H; rp.gpre = a.in[6]; rp.shv = modv + 0 * 2048; rp.scv = modv + 1 * 2048; rp.nrows = MROWS; row_pass(rp); }
    GSYNC();

    for (int l = 0; l < 2; ++l) {
        const bool last = (l == 1);
        const int mact = last ? MLAT : MROWS;
        const float* modl = modv + (size_t)l * 3 * 12288;
        { pg8::Gemm g{H, (const bf16_t*)(ws + WS_WIN), MROWS, NINP, D}; pg8::StaticOrder S; S.init(MROWS, NINP, G, bx);
          EpiStore16 E{P, NINP}; pg8::gemm_phase<EpiStore16, pg8::StaticOrder, true, true>(glds, g, S, E); }
        GSYNC();
        prep_phase(a, l, fl);
        la_phase(a, l);
        if (PROBE_DUP == 4) prep_phase(a, l, fl);
        GSYNC();
        prep2_phase(a, fl);
        GSYNC();
        ssd_state_phase(a, fl);
        __syncthreads();
        attn_phase(a, l, !last, lds);
        if (!last) { const int nfill = (G >= 128) ? G - 64 : G; __syncthreads(); wconv_phase(a, 0, fl, 2 | 4 | 8 | 16, 0, nfill); __syncthreads(); mod_phase(a, fl, modv, 128, 256, nfill); }
        if (PROBE_DUP == 1) { __syncthreads(); attn_phase(a, l, !last, lds); }
        if (PROBE_DUP == 2) { __syncthreads(); ssd_state_phase(a, fl); }
        GSYNC();
        s5_phase(a, l, lds);
        __syncthreads();
        ssd_out_phase(a, lds, last ? 1 : 0);
        if (PROBE_DUP == 2) { __syncthreads(); ssd_out_phase(a, lds, last ? 1 : 0); }
        if (PROBE_DUP == 3) { __syncthreads(); s5_phase(a, l, lds); }
        GSYNC();
        post_phase(a, l, mact);
        if (PROBE_DUP == 4) post_phase(a, l, mact);
        GSYNC();
        { pg8::Gemm g{AST, (const bf16_t*)(ws + WS_WSTK), mact, 2048, 1024}; pg8::MultiOrder S; S.init(mact, 2048, 3, MT, G, bx);
          EpiG1 E{AST + (size_t)3 * MROWS * 1024, a.in[28] + l * 2048, BR0, BR1, P}; pg8::gemm_phase<EpiG1, pg8::MultiOrder, true, true>(glds, g, S, E); }
        GSYNC();
        { pg8::Gemm g{AST + (size_t)3 * MROWS * 1024, (const bf16_t*)(ws + WS_WSTK) + (size_t)3 * 2048 * 1024, mact, 2048, 1024}; pg8::StaticOrder S; S.init(mact, 2048, G, bx);
          EpiG2 E{MRG, BR0, BR1, P}; pg8::gemm_phase<EpiG2, pg8::StaticOrder, true, true>(glds, g, S, E); }
        if (!last) { __syncthreads(); wconv_phase(a, 1, fl, 32, 16); }
        GSYNC();
        { pg8::Gemm g{MRG, (const bf16_t*)(ws + WS_WOUT), mact, 2048, 2048}; pg8::StaticOrder S; S.init(mact, 2048, G, bx);
          EpiStore16 E{OBH, D}; pg8::gemm_phase<EpiStore16, pg8::StaticOrder, true, true>(glds, g, S, E); }
        if (!last) { __syncthreads(); wconv_phase(a, 1, fl, 64, 16); }
        GSYNC();
        { RowPass rp{}; rp.src_lat = (l == 0) ? a.in[0] : a.out; rp.src_ctx = (l == 0) ? a.in[2] : xc; rp.dst_lat = a.out; rp.dst_ctx = xc; rp.o = OBH; rp.gpost = a.in[7] + l * D; rp.gatev = modl + 2 * 2048;
          rp.h = H; rp.gpre = a.in[8] + l * D; rp.shv = modl + 3 * 2048; rp.scv = modl + 4 * 2048; rp.nrows = mact; row_pass(rp); }
        GSYNC();
        { pg8::Gemm g{H, (const bf16_t*)(ws + WS_WGU), mact, 2 * DFF, D}; pg8::StaticOrder S; S.init(mact, 2 * DFF, G, bx);
          EpiPair<0> E{HFF, DFF, nullptr}; pg8::gemm_phase<EpiPair<0>, pg8::StaticOrder, true, true>(glds, g, S, E); }
        GSYNC();
        { pg8::Gemm g{HFF, (const bf16_t*)(ws + WS_WDN), mact, 2048, DFF}; pg8::StaticOrder S; S.init(mact, 2048, G, bx);
          EpiStore16 E{OBH, D}; pg8::gemm_phase<EpiStore16, pg8::StaticOrder, true, true>(glds, g, S, E); }
        if (!last) { __syncthreads(); wconv_phase(a, 1, fl, 2 | 4 | 8, 16); }
        GSYNC();
        { RowPass rp{}; rp.src_lat = a.out; rp.src_ctx = xc; rp.dst_lat = a.out; rp.dst_ctx = xc; rp.o = OBH; rp.gpost = a.in[9] + l * D; rp.gatev = modl + 5 * 2048;
          if (!last) { rp.h = H; rp.gpre = a.in[6] + D; rp.shv = modv + (size_t)3 * 12288 + 0 * 2048; rp.scv = modv + (size_t)3 * 12288 + 1 * 2048; }
          rp.nrows = mact; row_pass(rp); }
        if (!last) { __syncthreads(); wconv_phase(a, 1, fl, 16, 0); GSYNC(); }
    }
}

extern "C" void kernel_launch(void* const* d_in, const int* in_sizes, int n_in, void* d_out, int out_size, void* d_ws, size_t ws_size, hipStream_t stream) {
    static int grid_blocks = 0;
    if (!grid_blocks) {
        int dev = 0, cus = 0, per_cu = 0;
        (void)hipGetDevice(&dev);
        (void)hipDeviceGetAttribute(&cus, hipDeviceAttributeMultiprocessorCount, dev);
        (void)hipFuncSetAttribute((const void*)mega, hipFuncAttributeMaxDynamicSharedMemorySize, LDS_BYTES);
        (void)hipOccupancyMaxActiveBlocksPerMultiprocessor(&per_cu, (const void*)mega, NT, LDS_BYTES);
        if (per_cu < 1) per_cu = 1;
        if (per_cu > 1) per_cu = 1;
        grid_blocks = cus * per_cu;
        if (ws_size < WS_END) fprintf(stderr, "kernel_launch: workspace too small: %zu < %zu\n", ws_size, (size_t)WS_END);
    }
    (void)hipMemsetAsync((unsigned char*)d_ws + WS_BAR, 0, WS_BAR_BYTES, stream);
    Args a{};
    for (int i = 0; i < 34; ++i) a.in[i] = (const float*)d_in[i];
    a.out = (float*)d_out; a.ws = (unsigned char*)d_ws;
    void* args[] = {&a};
    hipError_t e = hipLaunchCooperativeKernel((void*)mega, dim3(grid_blocks), dim3(NT), args, LDS_BYTES, stream);
    if (e != hipSuccess) fprintf(stderr, "cooperative launch failed: %s (grid %d)\n", hipGetErrorString(e), grid_blocks);
}
```

```cpp
#include <hip/hip_runtime.h>
#include <hip/hip_cooperative_groups.h>
#include <cstdio>
#include <cstdint>
namespace cg = cooperative_groups;

__device__ __forceinline__ int otid() { int t = threadIdx.x; asm volatile("" : "+v"(t)); return t; }
__device__ __forceinline__ int obid() { int t = blockIdx.x; asm volatile("" : "+s"(t)); return t; }
namespace pg8 {
#define PG8_LAS __attribute__((address_space(3)))
typedef unsigned short bf16_t;
typedef short bf16x8 __attribute__((ext_vector_type(8)));
typedef float f32x4 __attribute__((ext_vector_type(4)));
typedef unsigned u32x4 __attribute__((ext_vector_type(4)));
constexpr int BM = 256, BK = 64, HALF = 128, HTB = HALF * BK * 2, STAGE_BYTES = 8 * HTB, NXCD = 8, WGM = 8;

__host__ __device__ __forceinline__ int lds_byte(int r, int c) { const int st = (r >> 4) * 2 + (c >> 5), rr = r & 15, cc = c & 31, ob = rr * 64 + cc * 2; return st * 1024 + (ob ^ (((ob >> 9) & 1) << 5)); }
__host__ __device__ __forceinline__ void stage_rc(int b, int& R, int& C) { const int st = b / 1024, sb = b % 1024, swz = sb ^ (((sb >> 9) & 1) << 5); R = (st >> 1) * 16 + swz / 64; C = (st & 1) * 32 + (swz % 64) / 2; }
__host__ __device__ __forceinline__ int perm32(int rho) { const int n = rho >> 4, i = rho & 15; return 8 * (i >> 2) + 4 * n + (i & 3); }

struct Unit { int pm, pn; };
struct Gemm { const bf16_t* A; const bf16_t* Bt; int M, N, K; };

struct StaticOrder {
    int nM, nN, nwg, G, c;
    __host__ __device__ void init(int M, int N, int G_, int c_) { nM = M / BM; nN = N / BM; nwg = nM * nN; G = G_; c = c_; }
    __host__ __device__ bool next(int i, Unit& u) const {
        const long L = (long)i * G + c; if (L >= nwg) return false;
        int wgid = (int)L; { const int q = nwg / NXCD, r = nwg % NXCD, xcd = wgid % NXCD, off = wgid / NXCD; wgid = (xcd < r ? xcd * (q + 1) : r * (q + 1) + (xcd - r) * q) + off; }
        const int nig = WGM * nN, gid = wgid / nig, fm = gid * WGM, gsz = (nM - fm) < WGM ? (nM - fm) : WGM;
        u.pm = fm + ((wgid % nig) % gsz); u.pn = (wgid % nig) / gsz; return true;
    }
    __device__ __forceinline__ void a_ready(const Unit&) const {}
    __device__ __forceinline__ void done(const Unit&) const {}
};
struct MultiOrder {
    StaticOrder so; int nN1, mstride;
    __host__ __device__ void init(int M, int N1, int ng, int mstride_, int G_, int c_) { so.init(M, N1 * ng, G_, c_); nN1 = N1 / BM; mstride = mstride_; }
    __host__ __device__ bool next(int i, Unit& u) const { if (!so.next(i, u)) return false; const int gi = u.pn / nN1; u.pm += gi * mstride; return true; }
    __device__ __forceinline__ void a_ready(const Unit&) const {}
    __device__ __forceinline__ void done(const Unit&) const {}
};

typedef float f32x2 __attribute__((ext_vector_type(2)));
typedef __bf16 bf16x2_t __attribute__((ext_vector_type(2)));
__device__ __forceinline__ unsigned cvt_pk_bf16(float lo, float hi) { f32x2 v = {lo, hi}; bf16x2_t b = __builtin_convertvector(v, bf16x2_t); return __builtin_bit_cast(unsigned, b); }

template <class Epi, class Sched, bool ALIGN_EPI = false, bool SP2 = false>
__device__ __forceinline__ void gemm_phase(PG8_LAS unsigned char* lds, const Gemm g, const Sched& S, const Epi& E) {
    const int tid = otid(), wid = __builtin_amdgcn_readfirstlane(tid >> 6), lane = tid & 63, wr = wid >> 2, wc = wid & 3, fr = lane & 15, fq = lane >> 4;
    const int K = g.K, nt = K / BK;
    unsigned voffA[2], voffB[2];
#pragma unroll
    for (int i = 0; i < 2; ++i) { int R, C; stage_rc(tid * 16 + i * 8192, R, C); const int Rb = Epi::PERM ? ((R & ~31) + perm32(R & 31)) : R;
        voffA[i] = (unsigned)(R * K + C) * 2u; voffB[i] = (unsigned)(Rb * K + C) * 2u; }
    const size_t kstep = (size_t)(BK * 2);
    const size_t hstep = (size_t)HALF * K * 2;
    const size_t tstep = 2 * hstep;
    const unsigned ldsw = (unsigned)wid * 1024u;
    const int aoff = lds_byte(wr * 64 + fr, fq * 8), boff = lds_byte(wc * 32 + fr, fq * 8);
#define PG8_SA(b, h) (((b) * 2 + (h)) * HTB)
#define PG8_SB(b, h) ((4 + (b) * 2 + (h)) * HTB)
#define PG8_STAGE(bufoff, gbase, voff) do { _Pragma("unroll") for (int _i = 0; _i < 2; ++_i) \
        __builtin_amdgcn_global_load_lds((const unsigned*)((const char*)(gbase) + (voff)[_i]), (PG8_LAS unsigned*)(lds + (bufoff) + ldsw + _i * 8192), 16, 0, 0); } while (0)
#define PG8_LDA(dst, b, h) do { _Pragma("unroll") for (int m = 0; m < 4; ++m) _Pragma("unroll") for (int k = 0; k < 2; ++k) dst[m][k] = *(const PG8_LAS bf16x8*)(lds + PG8_SA(b, h) + aoff + m * 2048 + k * 1024); } while (0)
#define PG8_LDB(dst, b, h) do { _Pragma("unroll") for (int n = 0; n < 2; ++n) _Pragma("unroll") for (int k = 0; k < 2; ++k) dst[n][k] = *(const PG8_LAS bf16x8*)(lds + PG8_SB(b, h) + boff + n * 2048 + k * 1024); } while (0)
#define PG8_MMA(ai, bj, At, Bt) do { __builtin_amdgcn_s_setprio(1); _Pragma("unroll") for (int m = 0; m < 4; ++m) _Pragma("unroll") for (int n = 0; n < 2; ++n) _Pragma("unroll") for (int k = 0; k < 2; ++k) \
        acc[ai][bj][m][n] = __builtin_amdgcn_mfma_f32_16x16x32_bf16(Bt[n][k], At[m][k], acc[ai][bj][m][n], 0, 0, 0); __builtin_amdgcn_s_setprio(0); } while (0)
#define PG8_WAIT_V(n) asm volatile("s_waitcnt vmcnt(" #n ")" ::: "memory")
#define PG8_WAIT_L(n) asm volatile("s_waitcnt lgkmcnt(" #n ")" ::: "memory")
#define PG8_BAR __builtin_amdgcn_s_barrier()
#define PG8_SCHED __builtin_amdgcn_sched_barrier(0)
    Unit cur, nxt; int ui = 0;
    if (!S.next(0, cur)) return;
    f32x4 acc[2][2][4][2];
#pragma unroll
    for (int a = 0; a < 2; ++a)
#pragma unroll
        for (int b = 0; b < 2; ++b)
#pragma unroll
            for (int m = 0; m < 4; ++m)
#pragma unroll
                for (int n = 0; n < 2; ++n) acc[a][b][m][n] = (f32x4){0.f, 0.f, 0.f, 0.f};
    bf16x8 At[4][2], B0[2][2], B1[2][2];
    const char* cA = (const char*)g.A + (size_t)cur.pm * tstep; const char* cB = (const char*)g.Bt + (size_t)cur.pn * tstep;
    S.a_ready(cur);
    if constexpr (SP2) {
        PG8_STAGE(PG8_SB(0, 0), cB, voffB); PG8_STAGE(PG8_SB(0, 1), cB + hstep, voffB); PG8_STAGE(PG8_SA(0, 0), cA, voffA); PG8_STAGE(PG8_SA(0, 1), cA + hstep, voffA);
        if (wr == 1) PG8_BAR;
        PG8_WAIT_V(2); PG8_BAR;
        PG8_STAGE(PG8_SB(1, 0), cB + kstep, voffB); PG8_STAGE(PG8_SA(1, 0), cA + kstep, voffA); PG8_STAGE(PG8_SB(1, 1), cB + hstep + kstep, voffB);
        PG8_WAIT_V(6); PG8_BAR;
    } else {
        PG8_STAGE(PG8_SB(0, 0), cB, voffB); PG8_STAGE(PG8_SA(0, 0), cA, voffA); PG8_STAGE(PG8_SB(0, 1), cB + hstep, voffB); PG8_STAGE(PG8_SA(0, 1), cA + hstep, voffA);
        if (wr == 1) PG8_BAR;
        PG8_WAIT_V(4); PG8_BAR;
        PG8_STAGE(PG8_SB(1, 0), cB + kstep, voffB); PG8_STAGE(PG8_SA(1, 0), cA + kstep, voffA); PG8_STAGE(PG8_SB(1, 1), cB + hstep + kstep, voffB);
        PG8_WAIT_V(6); PG8_BAR;
    }
    for (;;) {
        const bool has_next = S.next(ui + 1, nxt);
        const char* nA = has_next ? (const char*)g.A + (size_t)nxt.pm * tstep : cA; const char* nB = has_next ? (const char*)g.Bt + (size_t)nxt.pn * tstep : cB;
        for (int t = 0; t < nt; t += 2) {
            const bool last = (t == nt - 2);
            const char* a1 = cA + (size_t)(t + 1) * kstep;
            const char* a2 = last ? nA : cA + (size_t)(t + 2) * kstep; const char* b2 = last ? nB : cB + (size_t)(t + 2) * kstep;
            const char* a3 = a2 + kstep; const char* b3 = b2 + kstep;
            if (last && has_next) S.a_ready(nxt);
            if constexpr (SP2) {
            PG8_LDB(B0, 0, 0); PG8_LDB(B1, 0, 1); PG8_SCHED; PG8_LDA(At, 0, 0); PG8_STAGE(PG8_SA(1, 1), a1 + hstep, voffA);
            PG8_WAIT_V(8); PG8_WAIT_L(0); PG8_BAR; PG8_MMA(0, 0, At, B0); PG8_MMA(0, 1, At, B1); PG8_BAR; PG8_SCHED;
            PG8_LDA(At, 0, 1); PG8_STAGE(PG8_SB(0, 0), b2, voffB); PG8_STAGE(PG8_SB(0, 1), b2 + hstep, voffB); PG8_STAGE(PG8_SA(0, 0), a2, voffA);
            PG8_WAIT_V(8); PG8_WAIT_L(0); PG8_BAR; PG8_MMA(1, 0, At, B0); PG8_MMA(1, 1, At, B1); PG8_BAR; PG8_SCHED;
            PG8_LDB(B0, 1, 0); PG8_LDB(B1, 1, 1); PG8_SCHED; PG8_LDA(At, 1, 0); PG8_STAGE(PG8_SA(0, 1), a2 + hstep, voffA);
            PG8_WAIT_V(8); PG8_WAIT_L(0); PG8_BAR; PG8_MMA(0, 0, At, B0); PG8_MMA(0, 1, At, B1); PG8_BAR; PG8_SCHED;
            PG8_LDA(At, 1, 1); PG8_STAGE(PG8_SB(1, 0), b3, voffB); PG8_STAGE(PG8_SB(1, 1), b3 + hstep, voffB); PG8_STAGE(PG8_SA(1, 0), a3, voffA);
            PG8_WAIT_V(8); PG8_WAIT_L(0); PG8_BAR; PG8_MMA(1, 0, At, B0); PG8_MMA(1, 1, At, B1); PG8_BAR; PG8_SCHED;
            } else {
            PG8_LDB(B0, 0, 0); PG8_SCHED; PG8_LDA(At, 0, 0); PG8_STAGE(PG8_SA(1, 1), a1 + hstep, voffA);
            PG8_WAIT_L(8); PG8_BAR; PG8_WAIT_L(0); PG8_MMA(0, 0, At, B0); PG8_BAR; PG8_SCHED;
            PG8_LDB(B1, 0, 1); PG8_STAGE(PG8_SB(0, 0), b2, voffB);
            PG8_BAR; PG8_WAIT_L(0); PG8_MMA(0, 1, At, B1); PG8_BAR;
            PG8_LDA(At, 0, 1); PG8_STAGE(PG8_SA(0, 0), a2, voffA);
            PG8_BAR; PG8_WAIT_L(0); PG8_MMA(1, 0, At, B0); PG8_BAR; PG8_SCHED;
            PG8_STAGE(PG8_SB(0, 1), b2 + hstep, voffB);
            PG8_WAIT_V(6); PG8_BAR; PG8_MMA(1, 1, At, B1); PG8_BAR;
            PG8_LDB(B0, 1, 0); PG8_SCHED; PG8_LDA(At, 1, 0); PG8_STAGE(PG8_SA(0, 1), a2 + hstep, voffA);
            PG8_WAIT_L(8); PG8_BAR; PG8_WAIT_L(0); PG8_MMA(0, 0, At, B0); PG8_BAR; PG8_SCHED;
            PG8_LDB(B1, 1, 1); PG8_STAGE(PG8_SB(1, 0), b3, voffB);
            PG8_BAR; PG8_WAIT_L(0); PG8_MMA(0, 1, At, B1); PG8_BAR;
            PG8_LDA(At, 1, 1); PG8_STAGE(PG8_SA(1, 0), a3, voffA);
            PG8_BAR; PG8_WAIT_L(0); PG8_MMA(1, 0, At, B0); PG8_BAR; PG8_SCHED;
            PG8_STAGE(PG8_SB(1, 1), b3 + hstep, voffB);
            PG8_WAIT_V(6); PG8_BAR; PG8_MMA(1, 1, At, B1); PG8_BAR;
            }
        }
        if constexpr (ALIGN_EPI) { if (wr == 0) PG8_BAR; }
        E(acc, cur, wr, wc, fr, fq); S.done(cur);
        if (!has_next) break;
#pragma unroll
        for (int a = 0; a < 2; ++a)
#pragma unroll
            for (int b = 0; b < 2; ++b)
#pragma unroll
                for (int m = 0; m < 4; ++m)
#pragma unroll
                    for (int n = 0; n < 2; ++n) acc[a][b][m][n] = (f32x4){0.f, 0.f, 0.f, 0.f};
        cur = nxt; cA = nA; cB = nB; ++ui;
        if constexpr (ALIGN_EPI) { if (wr == 1) PG8_BAR; }
    }
    PG8_WAIT_V(0);
    if constexpr (!ALIGN_EPI) { if (wr == 0) PG8_BAR; }
    PG8_BAR;
#undef PG8_SA
#undef PG8_SB
#undef PG8_STAGE
#undef PG8_LDA
#undef PG8_LDB
#undef PG8_MMA
#undef PG8_WAIT_V
#undef PG8_WAIT_L
#undef PG8_BAR
#undef PG8_SCHED
}
}

using pg8::bf16_t; using pg8::f32x4; using pg8::u32x4; using pg8::bf16x8;
typedef float f32x16 __attribute__((ext_vector_type(16)));
typedef float f32x2v __attribute__((ext_vector_type(2)));
typedef unsigned u32x2 __attribute__((ext_vector_type(2)));
constexpr int D = 2048, SEQ = 4096, CTXL = 256, MLAT = 8192, MCTX = 512, MROWS = 8704, MT = 34;
constexpr int NIN = 12832, NINP = 13056;
constexpr int QOFF = 0, KOFF = 1024, VOFF = 2048, ZOFF = 3072, XBCOFF = 4096, DTOFF = 5632, UOFF = 5664, GATEOFF = 6688;
constexpr int DFF = 5632, KVL = 4352, NCH = 17;
constexpr float EPS = 1e-6f;
constexpr int NT = 512, NWAVES = 8;
constexpr int LDS_BYTES = 147456;
#ifndef PROBE_DUP
#define PROBE_DUP 0
#endif

constexpr size_t MiB = 1u << 20;
constexpr size_t WS_WIN = 0;
constexpr size_t WS_WSTK = 51 * MiB;
constexpr size_t WS_WOUT = 67 * MiB;
constexpr size_t WS_WGU = 75 * MiB;
constexpr size_t WS_WDN = 119 * MiB;
constexpr size_t WS_P = 141 * MiB;
constexpr size_t WS_H = 358 * MiB;
constexpr size_t WS_XC = 392 * MiB;
constexpr size_t WS_AST = 396 * MiB;
constexpr size_t WS_DTV = 464 * MiB;
constexpr size_t WS_MOD = 467 * MiB;
constexpr size_t WS_R2 = 468 * MiB;
constexpr size_t WS_QR = WS_R2;
constexpr size_t WS_KR = WS_R2 + 17 * MiB;
constexpr size_t WS_VT = WS_R2 + 34 * MiB;
constexpr size_t WS_XBC = WS_R2 + 51 * MiB;
constexpr size_t WS_YSSD = WS_R2 + 102 * MiB;
constexpr size_t WS_YS5 = WS_R2 + 170 * MiB;
constexpr size_t WS_HINB = WS_R2 + 238 * MiB;
constexpr size_t WS_LA = WS_R2 + 255 * MiB;
constexpr size_t WS_BN = WS_R2 + 257 * MiB;
constexpr size_t WS_CN = WS_R2 + 266 * MiB;
constexpr size_t WS_BT = WS_R2 + 275 * MiB;
constexpr size_t WS_XDT = WS_R2 + 284 * MiB;
constexpr size_t WS_BR0 = WS_R2;
constexpr size_t WS_BR1 = WS_R2 + 34 * MiB;
constexpr size_t WS_MRG = WS_R2 + 68 * MiB;
constexpr size_t WS_O = WS_R2 + 102 * MiB;
constexpr size_t WS_BAR = WS_R2 + 318 * MiB;
constexpr size_t WS_BAR_BYTES = 16384;
constexpr size_t WS_END = WS_BAR + 1 * MiB;

struct Args { const float* in[34]; float* out; unsigned char* ws; };

__device__ __forceinline__ float bf2f(unsigned v) { return __uint_as_float(v << 16); }
__device__ __forceinline__ unsigned pk2(float lo, float hi) { return pg8::cvt_pk_bf16(lo, hi); }
__device__ __forceinline__ void unpack8(const u32x4 w, float* f) {
    f[0] = __uint_as_float(w.x << 16); f[1] = __uint_as_float(w.x & 0xffff0000u); f[2] = __uint_as_float(w.y << 16); f[3] = __uint_as_float(w.y & 0xffff0000u);
    f[4] = __uint_as_float(w.z << 16); f[5] = __uint_as_float(w.z & 0xffff0000u); f[6] = __uint_as_float(w.w << 16); f[7] = __uint_as_float(w.w & 0xffff0000u);
}
__device__ __forceinline__ float sigmoidf_(float x) { return 1.f / (1.f + __expf(-x)); }
__device__ __forceinline__ float siluf_(float x) { return x / (1.f + __expf(-x)); }
__device__ __forceinline__ float wave_sum(float v) {
#pragma unroll
    for (int o = 1; o < 64; o <<= 1) v += __shfl_xor(v, o);
    return v;
}

struct EpiStore16 {
    static constexpr bool PERM = true;
    bf16_t* O; int ldc;
    __device__ __forceinline__ void operator()(const f32x4 (&acc)[2][2][4][2], const pg8::Unit& u, int wr, int wc, int fr, int fq) const {
        const int row0 = (u.pm % MT) * 256 + wr * 64 + fr, col0 = u.pn * 256 + wc * 32 + 8 * fq;
#pragma unroll
        for (int ai = 0; ai < 2; ++ai)
#pragma unroll
            for (int m = 0; m < 4; ++m) { bf16_t* rowp = O + (size_t)(row0 + ai * 128 + m * 16) * ldc + col0;
#pragma unroll
                for (int bj = 0; bj < 2; ++bj) { const f32x4 v0 = acc[ai][bj][m][0], v1 = acc[ai][bj][m][1];
                    u32x4 w; w.x = pk2(v0[0], v0[1]); w.y = pk2(v0[2], v0[3]); w.z = pk2(v1[0], v1[1]); w.w = pk2(v1[2], v1[3]);
                    *(u32x4*)(rowp + bj * 128) = w; } }
    }
};
template <int MODE> struct EpiPair {
    static constexpr bool PERM = true;
    bf16_t* O; int ldc; const float* bias;
    __device__ __forceinline__ void operator()(const f32x4 (&acc)[2][2][4][2], const pg8::Unit& u, int wr, int wc, int fr, int fq) const {
        const int row0 = (u.pm % MT) * 256 + wr * 64 + fr, col0 = u.pn * 128 + wc * 32 + 8 * fq;
        float ba[8], bb[8];
#pragma unroll
        for (int j = 0; j < 8; ++j) { ba[j] = (MODE == 1) ? bias[col0 + j] : 0.f; bb[j] = (MODE == 1) ? bias[1024 + col0 + j] : 0.f; }
#pragma unroll
        for (int ai = 0; ai < 2; ++ai)
#pragma unroll
            for (int m = 0; m < 4; ++m) { bf16_t* rowp = O + (size_t)(row0 + ai * 128 + m * 16) * ldc + col0;
                float o[8];
#pragma unroll
                for (int n = 0; n < 2; ++n)
#pragma unroll
                    for (int j = 0; j < 4; ++j) { const float a = acc[ai][0][m][n][j] + ba[4 * n + j], b = acc[ai][1][m][n][j] + bb[4 * n + j];
                        o[4 * n + j] = (MODE == 0) ? siluf_(a) * b : a * sigmoidf_(b); }
                u32x4 w; w.x = pk2(o[0], o[1]); w.y = pk2(o[2], o[3]); w.z = pk2(o[4], o[5]); w.w = pk2(o[6], o[7]);
                *(u32x4*)rowp = w; }
    }
};
struct EpiF32 {
    static constexpr bool PERM = false;
    float* O; int ldc;
    __device__ __forceinline__ void operator()(const f32x4 (&acc)[2][2][4][2], const pg8::Unit& u, int wr, int wc, int fr, int fq) const {
        const int row0 = (u.pm % MT) * 256 + wr * 64 + fr, col0 = u.pn * 256 + wc * 32 + 4 * fq;
#pragma unroll
        for (int ai = 0; ai < 2; ++ai)
#pragma unroll
            for (int m = 0; m < 4; ++m) { float* rowp = O + (size_t)(row0 + ai * 128 + m * 16) * ldc + col0;
#pragma unroll
                for (int bj = 0; bj < 2; ++bj)
#pragma unroll
                    for (int n = 0; n < 2; ++n) *(f32x4*)(rowp + bj * 128 + n * 16) = acc[ai][bj][m][n]; }
    }
};
struct EpiG1 {
    static constexpr bool PERM = true;
    bf16_t* ys5; const float* glu_bias; bf16_t* br0; bf16_t* br1; const bf16_t* P;
    __device__ __forceinline__ void operator()(const f32x4 (&acc)[2][2][4][2], const pg8::Unit& u, int wr, int wc, int fr, int fq) const {
        const int gi = u.pn >> 3, pn = u.pn & 7;
        if (gi == 0) { pg8::Unit u2; u2.pm = u.pm; u2.pn = pn; EpiPair<1> e{ys5, 1024, glu_bias}; e(acc, u2, wr, wc, fr, fq); return; }
        bf16_t* br = (gi == 1) ? br0 : br1;
        const int row0 = (u.pm % MT) * 256 + wr * 64 + fr, col0 = pn * 256 + wc * 32 + 8 * fq;
#pragma unroll
        for (int ai = 0; ai < 2; ++ai)
#pragma unroll
            for (int m = 0; m < 4; ++m) { const int row = row0 + ai * 128 + m * 16;
#pragma unroll
                for (int bj = 0; bj < 2; ++bj) { const int col = col0 + bj * 128;
                    const u32x4 gw = *(const u32x4*)(P + (size_t)row * NINP + GATEOFF + (gi - 1) * 2048 + col); float gt[8]; unpack8(gw, gt);
                    const f32x4 v0 = acc[ai][bj][m][0], v1 = acc[ai][bj][m][1];
                    float o[8];
#pragma unroll
                    for (int j = 0; j < 4; ++j) { o[j] = sigmoidf_(gt[j]) * v0[j]; o[4 + j] = sigmoidf_(gt[4 + j]) * v1[j]; }
                    u32x4 w; w.x = pk2(o[0], o[1]); w.y = pk2(o[2], o[3]); w.z = pk2(o[4], o[5]); w.w = pk2(o[6], o[7]);
                    *(u32x4*)(br + (size_t)row * D + col) = w; } }
    }
};
struct EpiG2 {
    static constexpr bool PERM = true;
    bf16_t* mrg; const bf16_t* br0; const bf16_t* br1; const bf16_t* P;
    __device__ __forceinline__ void operator()(const f32x4 (&acc)[2][2][4][2], const pg8::Unit& u, int wr, int wc, int fr, int fq) const {
        const int row0 = (u.pm % MT) * 256 + wr * 64 + fr, col0 = u.pn * 256 + wc * 32 + 8 * fq;
#pragma unroll
        for (int ai = 0; ai < 2; ++ai)
#pragma unroll
            for (int m = 0; m < 4; ++m) { const int row = row0 + ai * 128 + m * 16;
#pragma unroll
                for (int bj = 0; bj < 2; ++bj) { const int col = col0 + bj * 128;
                    const u32x4 gw = *(const u32x4*)(P + (size_t)row * NINP + GATEOFF + 2 * 2048 + col); float gt[8]; unpack8(gw, gt);
                    const u32x4 w0 = *(const u32x4*)(br0 + (size_t)row * D + col); float b0[8]; unpack8(w0, b0);
                    const u32x4 w1 = *(const u32x4*)(br1 + (size_t)row * D + col); float b1[8]; unpack8(w1, b1);
                    const f32x4 v0 = acc[ai][bj][m][0], v1 = acc[ai][bj][m][1];
                    float o[8];
#pragma unroll
                    for (int j = 0; j < 4; ++j) { o[j] = b0[j] + b1[j] + sigmoidf_(gt[j]) * v0[j]; o[4 + j] = b0[4 + j] + b1[4 + j] + sigmoidf_(gt[4 + j]) * v1[j]; }
                    u32x4 w; w.x = pk2(o[0], o[1]); w.y = pk2(o[2], o[3]); w.z = pk2(o[4], o[5]); w.w = pk2(o[6], o[7]);
                    *(u32x4*)(mrg + (size_t)row * D + col) = w; } }
    }
};

__device__ __forceinline__ void mod_phase(const Args& a, float* lds, float* modv, int g0, int g1, int nblk) {
    const int tid = otid();
    const float* c = a.in[1]; const float* cc = a.in[3]; const float* W = a.in[4]; const float* bvec = a.in[5];
    bool staged = false;
    const int bxm = obid(); if (bxm >= nblk) return;
    for (int gidx = g0 + bxm; gidx < g1; gidx += nblk) {
        if (!staged) {
            for (int i = tid; i < 3 * 2048; i += NT) { const int v = i >> 11, k = i & 2047; const float x = (v < 2) ? c[v * 2048 + k] : cc[k]; lds[i] = siluf_(x); }
            staged = true;
        }
        __syncthreads();
        const int l = gidx >> 7, j0 = (gidx & 127) * 96;
        const int kg = tid / 24, cl = tid % 24;
        float acc[3][4];
#pragma unroll
        for (int v = 0; v < 3; ++v)
#pragma unroll
            for (int j = 0; j < 4; ++j) acc[v][j] = 0.f;
        if (kg < 21) {
            const float* wp = W + (size_t)l * 2048 * 12288 + j0 + 4 * cl;
#pragma unroll 14
            for (int k = kg; k < 2048; k += 21) {
                const f32x4 w = *(const f32x4*)(wp + (size_t)k * 12288);
                const float s0 = lds[k], s1 = lds[2048 + k], s2 = lds[4096 + k];
#pragma unroll
                for (int j = 0; j < 4; ++j) { acc[0][j] += s0 * w[j]; acc[1][j] += s1 * w[j]; acc[2][j] += s2 * w[j]; }
            }
            float* red = lds + 6144;
#pragma unroll
            for (int v = 0; v < 3; ++v)
#pragma unroll
                for (int j = 0; j < 4; ++j) red[(kg * 3 + v) * 96 + 4 * cl + j] = acc[v][j];
        }
        __syncthreads();
        if (tid < 288) { const int v = tid / 96, cidx = tid % 96; float s = bvec[l * 12288 + j0 + cidx];
            for (int g = 0; g < 21; ++g) s += lds[6144 + (g * 3 + v) * 96 + cidx];
            modv[(l * 3 + v) * 12288 + j0 + cidx] = s; }
        __syncthreads();
    }
}

__device__ __forceinline__ void transpose_item(const float* W, int K, int N, bf16_t* WT, int k0, int n0, int drow0, float* scr, int lane) {
    float tv[32];
#pragma unroll
    for (int i = 0; i < 32; ++i) { const int kk = 2 * i + (lane >> 5); tv[i] = W[(size_t)(k0 + kk) * N + n0 + (lane & 31)]; }
#pragma unroll
    for (int i = 0; i < 32; ++i) { const int kk = 2 * i + (lane >> 5); scr[kk * 33 + (lane & 31)] = tv[i]; }
    asm volatile("s_waitcnt vmcnt(0) lgkmcnt(0)" ::: "memory");
    const int c = lane & 7;
#pragma unroll
    for (int j = 0; j < 4; ++j) { const int n = (lane >> 3) + 8 * j; const float* s = scr + (8 * c) * 33 + n;
        u32x4 o; o.x = pk2(s[0 * 33], s[1 * 33]); o.y = pk2(s[2 * 33], s[3 * 33]); o.z = pk2(s[4 * 33], s[5 * 33]); o.w = pk2(s[6 * 33], s[7 * 33]);
        *(u32x4*)(WT + (size_t)(drow0 + n) * K + k0 + 8 * c) = o; }
    asm volatile("s_waitcnt lgkmcnt(0)" ::: "memory");
}
__device__ __forceinline__ int pair_row(int n0, int part) { return (n0 >> 7) * 256 + part * 128 + (n0 & 127); }
__device__ __forceinline__ void wconv_phase(const Args& a, int l, float* lds, int parts = 31, int blk0 = 0, int nblk = 1 << 30) {
    const int tid = otid(), lane = tid & 63, wave = tid >> 6;
    float* scr = lds + wave * 4096;
    const int bxw = obid();
    const int bend = ((int)gridDim.x < nblk) ? (int)gridDim.x : nblk;
    if (bxw < blk0 || bxw >= bend) return;
    const int gw = (bxw - blk0) * NWAVES + wave, NGW = (bend - blk0) * NWAVES;
    unsigned char* ws = a.ws;
    constexpr int I_IN = 32 * 401, I_GLU = 16 * 64, I_WB = 3 * 16 * 64, I_OUT = 32 * 64, I_G = 32 * 176, I_DN = 88 * 64;
    constexpr int TOTAL = I_IN + I_GLU + I_WB + I_OUT + 2 * I_G + I_DN;
    for (int it = gw; it < TOTAL; it += NGW) {
        int r = it;
        if (r < I_IN) { if (!(parts & (1 | 32 | 64))) { it += (I_IN - r - 1) / NGW * NGW; continue; }
            if (!((parts & 1) || ((parts & 32) && r < I_IN / 2) || ((parts & 64) && r >= I_IN / 2))) continue;
            const int kb = r / 401, nb = r % 401; transpose_item(a.in[10] + (size_t)l * 2048 * NIN, 2048, NIN, (bf16_t*)(ws + WS_WIN), 64 * kb, 32 * nb, 32 * nb, scr, lane); continue; } r -= I_IN;
        if (r < I_GLU) { if (!(parts & 2)) continue; const int kb = r / 64, nb = r % 64, n0 = 32 * nb; const int dr = (n0 < 1024) ? pair_row(n0, 0) : pair_row(n0 - 1024, 1);
            transpose_item(a.in[27] + (size_t)l * 1024 * 2048, 1024, 2048, (bf16_t*)(ws + WS_WSTK), 64 * kb, n0, dr, scr, lane); continue; } r -= I_GLU;
        if (r < I_WB) { if (!(parts & 2)) continue; const int bi = r / 1024, rr = r % 1024, kb = rr / 64, nb = rr % 64;
            transpose_item(a.in[29] + ((size_t)l * 3 + bi) * 1024 * 2048, 1024, 2048, (bf16_t*)(ws + WS_WSTK) + (size_t)(1 + bi) * 2048 * 1024, 64 * kb, 32 * nb, 32 * nb, scr, lane); continue; } r -= I_WB;
        if (r < I_OUT) { if (!(parts & 4)) continue; const int kb = r / 64, nb = r % 64; transpose_item(a.in[30] + (size_t)l * 2048 * 2048, 2048, 2048, (bf16_t*)(ws + WS_WOUT), 64 * kb, 32 * nb, 32 * nb, scr, lane); continue; } r -= I_OUT;
        if (r < I_G) { if (!(parts & 8)) continue; const int kb = r / 176, nb = r % 176; transpose_item(a.in[31] + (size_t)l * 2048 * DFF, 2048, DFF, (bf16_t*)(ws + WS_WGU), 64 * kb, 32 * nb, pair_row(32 * nb, 0), scr, lane); continue; } r -= I_G;
        if (r < I_G) { if (!(parts & 8)) continue; const int kb = r / 176, nb = r % 176; transpose_item(a.in[32] + (size_t)l * 2048 * DFF, 2048, DFF, (bf16_t*)(ws + WS_WGU), 64 * kb, 32 * nb, pair_row(32 * nb, 1), scr, lane); continue; } r -= I_G;
        if (parts & 16) { const int kb = r / 64, nb = r % 64; transpose_item(a.in[33] + (size_t)l * DFF * 2048, DFF, 2048, (bf16_t*)(ws + WS_WDN), 64 * kb, 32 * nb, 32 * nb, scr, lane); }
    }
}

struct RowPass {
    const float* src_lat; const float* src_ctx;
    float* dst_lat; float* dst_ctx;
    const bf16_t* o;
    const float* gpost; const float* gatev;
    bf16_t* h;
    const float* gpre; const float* shv; const float* scv;
    int nrows;
};
__device__ __forceinline__ void row_pass(const RowPass& rp) {
    const int tid = otid(), lane = tid & 63, wave = tid >> 6;
    const int gw = obid() * NWAVES + wave, NGW = gridDim.x * NWAVES;
    for (int row = gw; row < rp.nrows; row += NGW) {
        const int v = (row < MLAT) ? (row >> 12) : 2;
        const float* xs = (row < MLAT) ? rp.src_lat + (size_t)row * D : rp.src_ctx + (size_t)(row - MLAT) * D;
        f32x4 x[8];
#pragma unroll
        for (int j = 0; j < 8; ++j) x[j] = *(const f32x4*)(xs + 4 * (lane + 64 * j));
        if (rp.o) {
            const bf16_t* orow = rp.o + (size_t)row * D; f32x4 ov[8]; float ss = 0.f;
#pragma unroll
            for (int j = 0; j < 8; ++j) { const u32x2 w2 = *(const u32x2*)(orow + 4 * (lane + 64 * j));
                ov[j] = (f32x4){__uint_as_float(w2.x << 16), __uint_as_float(w2.x & 0xffff0000u), __uint_as_float(w2.y << 16), __uint_as_float(w2.y & 0xffff0000u)};
                ss += ov[j][0] * ov[j][0] + ov[j][1] * ov[j][1] + ov[j][2] * ov[j][2] + ov[j][3] * ov[j][3]; }
            const float rstd = rsqrtf(wave_sum(ss) * (1.f / D) + EPS);
#pragma unroll
            for (int j = 0; j < 8; ++j) { const int col = 4 * (lane + 64 * j); const f32x4 gp = *(const f32x4*)(rp.gpost + col); const f32x4 gt = *(const f32x4*)(rp.gatev + v * 12288 + col);
                x[j] = x[j] + gt * (ov[j] * rstd * gp); }
        }
        if (rp.dst_lat) { float* xd = (row < MLAT) ? rp.dst_lat + (size_t)row * D : rp.dst_ctx + (size_t)(row - MLAT) * D;
#pragma unroll
            for (int j = 0; j < 8; ++j) *(f32x4*)(xd + 4 * (lane + 64 * j)) = x[j]; }
        if (rp.h) {
            float ss = 0.f;
#pragma unroll
            for (int j = 0; j < 8; ++j) ss += x[j][0] * x[j][0] + x[j][1] * x[j][1] + x[j][2] * x[j][2] + x[j][3] * x[j][3];
            const float rstd = rsqrtf(wave_sum(ss) * (1.f / D) + EPS);
            bf16_t* hr = rp.h + (size_t)row * D;
#pragma unroll
            for (int j = 0; j < 8; ++j) { const int col = 4 * (lane + 64 * j); const f32x4 gp = *(const f32x4*)(rp.gpre + col); const f32x4 sh = *(const f32x4*)(rp.shv + v * 12288 + col); const f32x4 sc = *(const f32x4*)(rp.scv + v * 12288 + col);
                const f32x4 y = (x[j] * rstd * gp) * (sc + 1.f) + sh; u32x2 w; w.x = pk2(y[0], y[1]); w.y = pk2(y[2], y[3]); *(u32x2*)(hr + col) = w; }
        }
    }
}

__device__ __forceinline__ int row_of_pos(int b, int pos) { return (pos < CTXL) ? MLAT + b * CTXL + pos : b * SEQ + (pos - CTXL); }
template <bool SRC_BF16> __device__ __forceinline__ void tr_tile(const void* src, int stride, int col0, int myrow, float myscale, bf16_t* dst, float* wl, int lane) {
    float* scr = wl; int* rws = (int*)(wl + 64 * 65); float* scs = wl + 64 * 65 + 64;
    rws[lane] = myrow; scs[lane] = myscale;
    asm volatile("s_waitcnt lgkmcnt(0)" ::: "memory");
#pragma unroll 32
    for (int i = 0; i < 64; ++i) { const int r = rws[i]; float v;
        if (SRC_BF16) v = bf2f(((const bf16_t*)src)[(size_t)r * stride + col0 + lane]); else v = ((const float*)src)[(size_t)r * stride + col0 + lane] * scs[i];
        scr[i * 65 + lane] = v; }
    asm volatile("s_waitcnt vmcnt(0) lgkmcnt(0)" ::: "memory");
    const int pb = lane & 7, cl = lane >> 3, ib = 32 * (pb >> 2) + 16 * ((pb >> 1) & 1) + 4 * (pb & 1);
#pragma unroll
    for (int k = 0; k < 8; ++k) { const int j = cl + 8 * k; float v[8];
#pragma unroll
        for (int jj = 0; jj < 8; ++jj) v[jj] = scr[(ib + 8 * (jj >> 2) + (jj & 3)) * 65 + j];
        u32x4 w; w.x = pk2(v[0], v[1]); w.y = pk2(v[2], v[3]); w.z = pk2(v[4], v[5]); w.w = pk2(v[6], v[7]);
        *(u32x4*)(dst + (size_t)j * KVL + 8 * pb) = w; }
    asm volatile("s_waitcnt lgkmcnt(0)" ::: "memory");
}
__device__ __forceinline__ int seq_row(int b, int dir, int s);
__device__ __forceinline__ void prep_phase(const Args& a, int l, float* lds) {
    unsigned char* ws = a.ws;
    const bf16_t* P = (const bf16_t*)(ws + WS_P);
    bf16_t* Qr = (bf16_t*)(ws + WS_QR); bf16_t* Kr = (bf16_t*)(ws + WS_KR); bf16_t* Vt = (bf16_t*)(ws + WS_VT);
    float* xbc = (float*)(ws + WS_XBC); float* dtv = (float*)(ws + WS_DTV);
    const int gt = obid() * NT + otid(), GT = gridDim.x * NT;
    const float qscale = 0.125f * 1.4426950408889634f;
    for (int idx = gt; idx < MROWS * 128; idx += GT) {
        const int oct = idx & 7, hc = (idx >> 3) & 15, row = idx >> 7;
        const bool lat = row < MLAT; const int b = lat ? (row >> 12) : ((row - MLAT) >> 8); const int t = lat ? (row & 4095) : ((row - MLAT) & 255);
        const bf16_t* srcq = P + (size_t)row * NINP + QOFF + hc * 64; const bf16_t* srck = P + (size_t)row * NINP + KOFF + hc * 64;
        const u32x4 xqw = *(const u32x4*)(srcq + oct * 8), xkw = *(const u32x4*)(srck + oct * 8);
        const u32x4 pqw = *(const u32x4*)(srcq + (oct ^ 2) * 8), pkw = *(const u32x4*)(srck + (oct ^ 2) * 8);
        float xq[8], xk[8], oq[8], ok[8]; unpack8(xqw, xq); unpack8(xkw, xk);
        if (lat) {
            float pq[8], pk[8]; unpack8(pqw, pq); unpack8(pkw, pk);
            const float sign = (oct & 2) ? 1.f : -1.f; const float pos = (float)((oct & 4) ? (t & 63) : (t >> 6));
#pragma unroll
            for (int j = 0; j < 8; ++j) { const int f = (oct & 1) * 8 + j; const float inv = exp2f(-(float)f * 0.8304820237218406f); const float ang = pos * inv; float sn, cs; __sincosf(ang, &sn, &cs);
                oq[j] = (xq[j] * cs + sign * pq[j] * sn) * qscale; ok[j] = xk[j] * cs + sign * pk[j] * sn; }
        } else {
#pragma unroll
            for (int j = 0; j < 8; ++j) { oq[j] = xq[j] * qscale; ok[j] = xk[j]; }
        }
        const int pos4 = lat ? CTXL + t : t;
        const size_t dofs = ((size_t)(b * 16 + hc) * KVL + pos4) * 64 + oct * 8;
        u32x4 w; w.x = pk2(oq[0], oq[1]); w.y = pk2(oq[2], oq[3]); w.z = pk2(oq[4], oq[5]); w.w = pk2(oq[6], oq[7]);
        *(u32x4*)(Qr + dofs) = w;
        w.x = pk2(ok[0], ok[1]); w.y = pk2(ok[2], ok[3]); w.z = pk2(ok[4], ok[5]); w.w = pk2(ok[6], ok[7]);
        *(u32x4*)(Kr + dofs) = w;
    }
    { const int tid_ = otid(); const int lane = tid_ & 63, wave = tid_ >> 6; float* wl = lds + wave * 4288;
      const int gw = obid() * NWAVES + wave, NGW = gridDim.x * NWAVES;
      for (int tI = gw; tI < 16 * 2 * 68; tI += NGW) { const int pt = tI % 68, rest = tI / 68, dh = rest & 1, bh = rest >> 1, b = bh >> 3, h = bh & 7;
          tr_tile<true>(P, NINP, VOFF + h * 128 + 64 * dh, row_of_pos(b, 64 * pt + lane), 1.f, Vt + ((size_t)bh * 128 + 64 * dh) * KVL + 64 * pt, wl, lane); } }
    const float* cw = a.in[13] + (size_t)l * 5 * 1536; const float* cb = a.in[14] + (size_t)l * 1536;
    for (int idx = gt; idx < MROWS * 192; idx += GT) {
        const int k8 = idx % 192, row = idx / 192, ch0 = 8 * k8;
        const bool lat = row < MLAT; const int t = lat ? (row & 4095) : ((row - MLAT) & 255); const int n = lat ? SEQ : CTXL;
        float acc[8];
        { const f32x4 b0 = *(const f32x4*)(cb + ch0), b1 = *(const f32x4*)(cb + ch0 + 4);
#pragma unroll
          for (int j = 0; j < 4; ++j) { acc[j] = b0[j]; acc[4 + j] = b1[j]; } }
#pragma unroll
        for (int j = 0; j < 5; ++j) { const int tt = t + j - 2;
            if (tt >= 0 && tt < n) { const u32x4 xw = *(const u32x4*)(P + (size_t)(row + j - 2) * NINP + XBCOFF + ch0); float x[8]; unpack8(xw, x);
                const f32x4 w0 = *(const f32x4*)(cw + j * 1536 + ch0), w1 = *(const f32x4*)(cw + j * 1536 + ch0 + 4);
#pragma unroll
                for (int q = 0; q < 4; ++q) { acc[q] += w0[q] * x[q]; acc[4 + q] += w1[q] * x[4 + q]; } } }
        f32x4 o0, o1;
#pragma unroll
        for (int q = 0; q < 4; ++q) { o0[q] = siluf_(acc[q]); o1[q] = siluf_(acc[4 + q]); }
        *(f32x4*)(xbc + (size_t)row * 1536 + ch0) = o0; *(f32x4*)(xbc + (size_t)row * 1536 + ch0 + 4) = o1;
    }
    const float* dtb = a.in[15] + l * 32; const float* alog = a.in[16] + l * 32;
    for (int idx = gt; idx < MROWS * 32; idx += GT) {
        const int i = idx & 31, row = idx >> 5;
        const float v = bf2f(P[(size_t)row * NINP + DTOFF + i]) + dtb[i];
        const float dt = fmaxf(v, 0.f) + log1pf(__expf(-fabsf(v)));
        const float av = -__expf(alog[i]);
        dtv[row * 64 + i] = dt; dtv[row * 64 + 32 + i] = __expf(dt * av);
    }
}

#define MFMA32(a, b, c) __builtin_amdgcn_mfma_f32_32x32x16_bf16((a), (b), (c), 0, 0, 0)
__device__ __forceinline__ void attn_phase(const Args& a, int l, bool with_ctx, unsigned char* lds) {
    unsigned char* ws = a.ws;
    const bf16_t* Qr = (const bf16_t*)(ws + WS_QR); const bf16_t* Kr = (const bf16_t*)(ws + WS_KR); const bf16_t* Vt = (const bf16_t*)(ws + WS_VT);
    bf16_t* yat = (bf16_t*)(ws + WS_AST) + (size_t)1 * MROWS * 1024;
    const int tid = otid(), lane = tid & 63, wid = tid >> 6, r32 = lane & 31, hi = lane >> 5, c = wid & 1, qsub = wid >> 1;
    constexpr int KT = 2 * 64 * 144, VTB = 128 * 144, BUF = KT + VTB;
    float* xch = (float*)(lds + 2 * BUF);
    const float lam_init = 0.8f - 0.6f * __expf(-0.3f * (float)l);
    float lam;
    { const float* lf = a.in[11] + l * 256; float s1 = 0.f, s2 = 0.f;
      for (int i = 0; i < 64; ++i) { s1 += lf[i] * lf[64 + i]; s2 += lf[128 + i] * lf[192 + i]; }
      lam = __expf(s1) - __expf(s2) + lam_init; }
    const float* subln = a.in[12] + l * 128;
    const int G = gridDim.x, bx = obid();
    const int vcu = (G % 8 == 0) ? (bx % 8) * (G / 8) + bx / 8 : bx;
    const int skey = tid >> 3, spart = tid & 7;
    const int nunits = with_ctx ? 544 : 512;
    for (int u0 = 2 * vcu; u0 < nunits; u0 += 2 * G) {
      for (int it = 0; it < 2; ++it) {
        const int u = u0 + it;
        int bh, qbase, nkv;
        if (u < 512) { bh = u >> 5; qbase = CTXL + 128 * (u & 31); nkv = KVL; } else { bh = (u - 512) >> 1; qbase = 128 * ((u - 512) & 1); nkv = CTXL; }
        const int b = bh >> 3, h = bh & 7;
        const bf16_t* Kg0 = Kr + ((size_t)(bh * 2) * KVL + skey) * 64 + spart * 8;
        const bf16_t* Kg1 = Kg0 + (size_t)KVL * 64;
        const bf16_t* Vg0 = Vt + ((size_t)bh * 128 + skey) * KVL + spart * 8;
        const bf16_t* Vg1 = Vg0 + (size_t)64 * KVL;
        unsigned char* kdst = lds + skey * 144 + spart * 16;
        unsigned char* vdst = lds + KT + skey * 144 + spart * 16;
        const int qpos = qbase + qsub * 32 + r32;
        bf16x8 qf[4];
        { const bf16_t* Qb = Qr + ((size_t)(bh * 2 + c) * KVL + qpos) * 64 + 8 * hi;
#pragma unroll
          for (int d0 = 0; d0 < 4; ++d0) qf[d0] = *(const bf16x8*)(Qb + 16 * d0); }
        f32x16 O[4];
#pragma unroll
        for (int j = 0; j < 4; ++j)
#pragma unroll
            for (int r = 0; r < 16; ++r) O[j][r] = 0.f;
        float negm = 0.f, lrun = 0.f; bool first = true;
        u32x4 k0 = *(const u32x4*)Kg0, k1 = *(const u32x4*)Kg1, v0 = *(const u32x4*)Vg0, v1 = *(const u32x4*)Vg1;
        __syncthreads();
        *(u32x4*)kdst = k0; *(u32x4*)(kdst + 9216) = k1; *(u32x4*)vdst = v0; *(u32x4*)(vdst + 9216) = v1;
        __syncthreads();
        const int nt = nkv >> 6;
        for (int t = 0; t < nt; ++t) {
            const int cur = t & 1;
            if (t + 1 < nt) { k0 = *(const u32x4*)(Kg0 + (size_t)(t + 1) * 64 * 64); k1 = *(const u32x4*)(Kg1 + (size_t)(t + 1) * 64 * 64);
                              v0 = *(const u32x4*)(Vg0 + (t + 1) * 64); v1 = *(const u32x4*)(Vg1 + (t + 1) * 64); }
#pragma unroll
            for (int sub = 0; sub < 2; ++sub) {
                const unsigned char* kb = lds + cur * BUF + c * 9216 + (32 * sub + r32) * 144 + hi * 16;
                const unsigned char* vb = lds + cur * BUF + KT + r32 * 144 + 64 * sub + hi * 16;
                bf16x8 kf[4], vf[8];
#pragma unroll
                for (int d0 = 0; d0 < 4; ++d0) kf[d0] = *(const bf16x8*)(kb + d0 * 32);
#pragma unroll
                for (int j = 0; j < 4; ++j) { vf[2 * j] = *(const bf16x8*)(vb + j * 32 * 144); vf[2 * j + 1] = *(const bf16x8*)(vb + j * 32 * 144 + 32); }
                __builtin_amdgcn_sched_barrier(0);
                f32x16 S;
#pragma unroll
                for (int r = 0; r < 16; ++r) S[r] = negm;
#pragma unroll
                for (int d0 = 0; d0 < 4; ++d0) S = MFMA32(kf[d0], qf[d0], S);
                float mx = S[0];
#pragma unroll
                for (int r = 1; r < 16; ++r) mx = fmaxf(mx, S[r]);
                if (first || __any(mx > 8.f)) {
                    mx = fmaxf(mx, __shfl_xor(mx, 32));
                    const float dl = first ? mx : fmaxf(mx, 0.f); const float alpha = first ? 1.f : __builtin_amdgcn_exp2f(-dl); negm -= dl; lrun *= alpha; first = false;
#pragma unroll
                    for (int r = 0; r < 16; ++r) S[r] -= dl;
#pragma unroll
                    for (int j = 0; j < 4; ++j)
#pragma unroll
                        for (int r = 0; r < 16; ++r) O[j][r] *= alpha;
                }
                float ps = 0.f;
#pragma unroll
                for (int r = 0; r < 16; ++r) { S[r] = __builtin_amdgcn_exp2f(S[r]); ps += S[r]; }
                lrun += ps;
                u32x4 p0, p1;
                p0.x = pk2(S[0], S[1]); p0.y = pk2(S[2], S[3]); p0.z = pk2(S[4], S[5]); p0.w = pk2(S[6], S[7]);
                p1.x = pk2(S[8], S[9]); p1.y = pk2(S[10], S[11]); p1.z = pk2(S[12], S[13]); p1.w = pk2(S[14], S[15]);
                const bf16x8 pa0 = __builtin_bit_cast(bf16x8, p0), pa1 = __builtin_bit_cast(bf16x8, p1);
#pragma unroll
                for (int j = 0; j < 4; ++j) O[j] = MFMA32(vf[2 * j], pa0, O[j]);
#pragma unroll
                for (int j = 0; j < 4; ++j) O[j] = MFMA32(vf[2 * j + 1], pa1, O[j]);
            }
            if (t + 1 < nt) { unsigned char* kd = kdst + (cur ^ 1) * BUF; unsigned char* vd = vdst + (cur ^ 1) * BUF;
                *(u32x4*)kd = k0; *(u32x4*)(kd + 9216) = k1; *(u32x4*)vd = v0; *(u32x4*)(vd + 9216) = v1; }
            __syncthreads();
        }
        const float ltot = lrun + __shfl_xor(lrun, 32); const float inv = 1.f / ltot;
        float* xp = xch + qsub * 4096 + lane;
        if (c == 1) { const float li = lam * inv;
#pragma unroll
            for (int j = 0; j < 4; ++j)
#pragma unroll
                for (int r = 0; r < 16; ++r) xp[(j * 16 + r) * 64] = li * O[j][r]; }
        __syncthreads();
        if (c == 0) {
            float ss = 0.f;
#pragma unroll
            for (int j = 0; j < 4; ++j)
#pragma unroll
                for (int r = 0; r < 16; ++r) { const float v = O[j][r] * inv - xp[(j * 16 + r) * 64]; O[j][r] = v; ss += v * v; }
            ss += __shfl_xor(ss, 32);
            const float sc = rsqrtf(ss * (1.f / 128.f) + EPS) * (1.f - lam_init);
            const int row = row_of_pos(b, qpos);
            bf16_t* orow = yat + (size_t)row * 1024 + h * 128;
#pragma unroll
            for (int j = 0; j < 4; ++j)
#pragma unroll
                for (int rq = 0; rq < 4; ++rq) { const int dv = 32 * j + 8 * rq + 4 * hi; const f32x4 g = *(const f32x4*)(subln + dv);
                    u32x2 w; w.x = pk2(O[j][4 * rq] * sc * g[0], O[j][4 * rq + 1] * sc * g[1]); w.y = pk2(O[j][4 * rq + 2] * sc * g[2], O[j][4 * rq + 3] * sc * g[3]);
                    *(u32x2*)(orow + dv) = w; }
        }
      }
    }
}

__device__ __forceinline__ int seq_row(int b, int dir, int s) {
    if (s < CTXL) return MLAT + b * CTXL + (dir ? (CTXL - 1 - s) : s);
    const int t = s - CTXL; return b * SEQ + (dir ? (SEQ - 1 - t) : t);
}
__device__ __forceinline__ void la_phase(const Args& a, int l) {
    unsigned char* ws = a.ws;
    const bf16_t* P = (const bf16_t*)(ws + WS_P); float* LA = (float*)(ws + WS_LA);
    const float* dtb = a.in[15] + l * 32; const float* alog = a.in[16] + l * 32;
    const int tid = otid(), lane = tid & 63, wave = tid >> 6;
    const int gw = obid() * NWAVES + wave, NGW = gridDim.x * NWAVES;
    for (int u = gw; u < 64 * NCH; u += NGW) {
        const int combo = u % 64, ch = u / 64, head = combo & 15, dir = (combo >> 4) & 1, b = combo >> 5;
        const int i = dir * 16 + head; const float av = -__expf(alog[i]), bias = dtb[i];
        float v[4]; float run = 0.f;
#pragma unroll
        for (int k = 0; k < 4; ++k) { const int sp = ch * 256 + lane * 4 + k; const int row = seq_row(b, dir, sp);
            const float x = bf2f(P[(size_t)row * NINP + DTOFF + i]) + bias; const float dt = fmaxf(x, 0.f) + log1pf(__expf(-fabsf(x)));
            run += dt * av; v[k] = run; }
        float incl = run;
#pragma unroll
        for (int o = 1; o < 64; o <<= 1) { const float t = __shfl_up(incl, o); if (lane >= o) incl += t; }
        const float excl = incl - run;
        *(f32x4*)(LA + (size_t)combo * KVL + ch * 256 + lane * 4) = (f32x4){v[0] + excl, v[1] + excl, v[2] + excl, v[3] + excl};
    }
}
__device__ __forceinline__ void prep2_phase(const Args& a, float* lds) {
    unsigned char* ws = a.ws;
    const float* xbc = (const float*)(ws + WS_XBC); const float* dtv = (const float*)(ws + WS_DTV);
    bf16_t* XDT = (bf16_t*)(ws + WS_XDT); bf16_t* BT = (bf16_t*)(ws + WS_BT); bf16_t* BN = (bf16_t*)(ws + WS_BN); bf16_t* CN = (bf16_t*)(ws + WS_CN);
    const int gt = obid() * NT + otid(), GT = gridDim.x * NT;
    { const int tid_ = otid(); const int lane = tid_ & 63, wave = tid_ >> 6; float* wl = lds + wave * 4288;
      const int gw = obid() * NWAVES + wave, NGW = gridDim.x * NWAVES;
      for (int tI = gw; tI < 4 * 16 * 68 + 8 * 2 * 68; tI += NGW) {
          if (tI < 4 * 16 * 68) { const int pt = tI % 68, rest = tI / 68, head = rest & 15, bd = rest >> 4, b = bd >> 1, dir = bd & 1;
              const int row = seq_row(b, dir, 64 * pt + lane);
              tr_tile<false>(xbc, 1536, head * 64, row, dtv[row * 64 + dir * 16 + head], XDT + ((size_t)bd * 1024 + head * 64) * KVL + 64 * pt, wl, lane);
          } else { const int t2 = tI - 4 * 16 * 68; const int pt = t2 % 68, rest = t2 / 68, nh = rest & 1, bdg = rest >> 1, g = bdg & 1, dir = (bdg >> 1) & 1, b = bdg >> 2;
              tr_tile<false>(xbc, 1536, 1024 + g * 128 + 64 * nh, seq_row(b, dir, 64 * pt + lane), 1.f, BT + ((size_t)bdg * 128 + 64 * nh) * KVL + 64 * pt, wl, lane); }
      } }
    for (int idx = gt; idx < 8 * KVL * 16; idx += GT) {
        const int oct = idx & 15, rest = idx >> 4, sp = rest % KVL, bdg = rest / KVL, g = bdg & 1, dir = (bdg >> 1) & 1, b = bdg >> 2;
        const int row = seq_row(b, dir, sp);
        const float* src = xbc + (size_t)row * 1536 + 1024 + g * 128 + oct * 8;
        const f32x4 b0 = *(const f32x4*)src, b1 = *(const f32x4*)(src + 4), c0 = *(const f32x4*)(src + 256), c1 = *(const f32x4*)(src + 260);
        u32x4 w; w.x = pk2(b0[0], b0[1]); w.y = pk2(b0[2], b0[3]); w.z = pk2(b1[0], b1[1]); w.w = pk2(b1[2], b1[3]);
        *(u32x4*)(BN + ((size_t)bdg * KVL + sp) * 128 + oct * 8) = w;
        w.x = pk2(c0[0], c0[1]); w.y = pk2(c0[2], c0[3]); w.z = pk2(c1[0], c1[1]); w.w = pk2(c1[2], c1[3]);
        *(u32x4*)(CN + ((size_t)bdg * KVL + sp) * 128 + oct * 8) = w;
    }
}
__device__ __forceinline__ void ssd_state_phase(const Args& a, float* lds) {
    unsigned char* ws = a.ws;
    const bf16_t* XDT = (const bf16_t*)(ws + WS_XDT); const bf16_t* BT = (const bf16_t*)(ws + WS_BT); const float* LA = (const float*)(ws + WS_LA);
    bf16_t* HINB = (bf16_t*)(ws + WS_HINB);
    const int tid = otid(), lane = tid & 63, wid = tid >> 6, r32 = lane & 31, hi = lane >> 5, pb = wid & 1, nb = wid >> 1;
    const int sblk0 = ((int)gridDim.x >= 128) ? (int)gridDim.x - 64 : 0;
    for (int combo = obid() - sblk0; combo < 64; combo += (int)gridDim.x - sblk0) {
        if (combo < 0) break;
        const int head = combo & 15, bd = combo >> 4, g = head >> 3;
        const bf16_t* xa = XDT + ((size_t)bd * 1024 + head * 64 + 32 * pb + r32) * KVL + 8 * hi;
        const bf16_t* bb = BT + ((size_t)(bd * 2 + g) * 128 + 32 * nb + r32) * KVL + 8 * hi;
        f32x16 Hs;
#pragma unroll
        for (int r = 0; r < 16; ++r) Hs[r] = 0.f;
        for (int c = 0; c < NCH; ++c) {
            bf16_t* hout = HINB + ((size_t)(combo * NCH + c)) * 8192 + 32 * nb + r32;
#pragma unroll
            for (int r = 0; r < 16; ++r) { const int p = 32 * pb + (r & 3) + 8 * (r >> 2) + 4 * hi; hout[p * 128] = (bf16_t)(pk2(Hs[r], 0.f) & 0xffffu); }
            if (c == NCH - 1) break;
            const float* lac = LA + (size_t)combo * KVL + c * 256;
            const float lalast = lac[255];
            __syncthreads();
            if (tid < 256) { const int tok = (tid & ~12) | ((tid & 4) << 1) | ((tid & 8) >> 1); lds[tid] = __expf(lalast - lac[tok]); }
            __syncthreads();
            f32x16 S;
#pragma unroll
            for (int r = 0; r < 16; ++r) S[r] = 0.f;
#pragma unroll
            for (int k = 0; k < 16; ++k) {
                const u32x4 xw = *(const u32x4*)(xa + c * 256 + 16 * k); const bf16x8 bf = *(const bf16x8*)(bb + c * 256 + 16 * k);
                float xv[8]; unpack8(xw, xv);
                const f32x4 w0 = *(const f32x4*)(lds + 16 * k + 8 * hi), w1 = *(const f32x4*)(lds + 16 * k + 8 * hi + 4);
                u32x4 sw; sw.x = pk2(xv[0] * w0[0], xv[1] * w0[1]); sw.y = pk2(xv[2] * w0[2], xv[3] * w0[3]); sw.z = pk2(xv[4] * w1[0], xv[5] * w1[1]); sw.w = pk2(xv[6] * w1[2], xv[7] * w1[3]);
                S = MFMA32(__builtin_bit_cast(bf16x8, sw), bf, S);
            }
            const float dec = __expf(lalast);
#pragma unroll
            for (int r = 0; r < 16; ++r) Hs[r] = Hs[r] * dec + S[r];
        }
    }
}
__device__ __forceinline__ void ssd_out_phase(const Args& a, unsigned char* lds, int ch_lo) {
    unsigned char* ws = a.ws;
    const bf16_t* XDT = (const bf16_t*)(ws + WS_XDT); const bf16_t* BN = (const bf16_t*)(ws + WS_BN); const bf16_t* CN = (const bf16_t*)(ws + WS_CN);
    const bf16_t* HINB = (const bf16_t*)(ws + WS_HINB); const float* LA = (const float*)(ws + WS_LA); bf16_t* yssd = (bf16_t*)(ws + WS_YSSD);
    const int tid = otid(), lane = tid & 63, w = tid >> 6, r32 = lane & 31, hi = lane >> 5;
    constexpr int BNS = 0, XTS = 256 * 272, HNS = XTS + 64 * 528, LAS_ = HNS + 64 * 272;
    const float* la_s = (const float*)(lds + LAS_);
    const int nunits = 64 * (NCH - ch_lo);
    for (int u = obid(); u < nunits; u += gridDim.x) {
        const int combo = u % 64, c = ch_lo + u / 64;
        const int head = combo & 15, bd = combo >> 4, dir = bd & 1, b = bd >> 1, g = head >> 3;
        u32x4 sb[8], sx[4], sh[2];
        { const bf16_t* src = BN + ((size_t)(bd * 2 + g) * KVL + c * 256) * 128;
#pragma unroll
          for (int it = 0; it < 8; ++it) { const int q = tid + NT * it; sb[it] = *(const u32x4*)(src + (size_t)(q >> 4) * 128 + (q & 15) * 8); } }
        { const bf16_t* src = XDT + ((size_t)bd * 1024 + head * 64) * KVL + c * 256;
#pragma unroll
          for (int it = 0; it < 4; ++it) { const int q = tid + NT * it; sx[it] = *(const u32x4*)(src + (size_t)(q >> 5) * KVL + (q & 31) * 8); } }
        { const bf16_t* src = HINB + ((size_t)(combo * NCH + c)) * 8192;
#pragma unroll
          for (int it = 0; it < 2; ++it) { const int q = tid + NT * it; sh[it] = *(const u32x4*)(src + (size_t)q * 8); } }
        const float lav = (tid < 256) ? LA[(size_t)combo * KVL + c * 256 + tid] : 0.f;
        const int qi = 32 * w + r32;
        bf16x8 qf[8];
        { const bf16_t* cq = CN + ((size_t)(bd * 2 + g) * KVL + c * 256 + qi) * 128 + 8 * hi;
#pragma unroll
          for (int kn = 0; kn < 8; ++kn) qf[kn] = *(const bf16x8*)(cq + 16 * kn); }
        __syncthreads();
#pragma unroll
        for (int it = 0; it < 8; ++it) { const int q = tid + NT * it; *(u32x4*)(lds + BNS + (q >> 4) * 272 + (q & 15) * 16) = sb[it]; }
#pragma unroll
        for (int it = 0; it < 4; ++it) { const int q = tid + NT * it; *(u32x4*)(lds + XTS + (q >> 5) * 528 + (q & 31) * 16) = sx[it]; }
#pragma unroll
        for (int it = 0; it < 2; ++it) { const int q = tid + NT * it; *(u32x4*)(lds + HNS + (q >> 4) * 272 + (q & 15) * 16) = sh[it]; }
        if (tid < 256) ((float*)(lds + LAS_))[tid] = lav;
        __syncthreads();
        const float lai = la_s[qi];
        f32x16 Oo[2], O[2];
#pragma unroll
        for (int pb = 0; pb < 2; ++pb)
#pragma unroll
            for (int r = 0; r < 16; ++r) { Oo[pb][r] = 0.f; O[pb][r] = 0.f; }
#pragma unroll
        for (int pb = 0; pb < 2; ++pb)
#pragma unroll
            for (int kn = 0; kn < 8; ++kn) { const bf16x8 hf = *(const bf16x8*)(lds + HNS + (32 * pb + r32) * 272 + 32 * kn + 16 * hi); Oo[pb] = MFMA32(hf, qf[kn], Oo[pb]); }
        for (int jb = 0; jb <= w; ++jb) {
            bf16x8 kf[8], vf[4];
#pragma unroll
            for (int kn = 0; kn < 8; ++kn) kf[kn] = *(const bf16x8*)(lds + BNS + (32 * jb + r32) * 272 + 32 * kn + 16 * hi);
#pragma unroll
            for (int pb = 0; pb < 2; ++pb) { vf[2 * pb] = *(const bf16x8*)(lds + XTS + (32 * pb + r32) * 528 + 64 * jb + 16 * hi); vf[2 * pb + 1] = *(const bf16x8*)(lds + XTS + (32 * pb + r32) * 528 + 64 * jb + 32 + 16 * hi); }
            f32x16 S;
#pragma unroll
            for (int r = 0; r < 16; ++r) S[r] = 0.f;
#pragma unroll
            for (int kn = 0; kn < 8; ++kn) S = MFMA32(kf[kn], qf[kn], S);
#pragma unroll
            for (int q = 0; q < 4; ++q) { const f32x4 lj = *(const f32x4*)(la_s + 32 * jb + 8 * q + 4 * hi);
#pragma unroll
                for (int e = 0; e < 4; ++e) { const int j = 32 * jb + 8 * q + 4 * hi + e; const float wgt = (j <= qi) ? __expf(fminf(lai - lj[e], 0.f)) : 0.f; S[4 * q + e] *= wgt; } }
            u32x4 p0, p1;
            p0.x = pk2(S[0], S[1]); p0.y = pk2(S[2], S[3]); p0.z = pk2(S[4], S[5]); p0.w = pk2(S[6], S[7]);
            p1.x = pk2(S[8], S[9]); p1.y = pk2(S[10], S[11]); p1.z = pk2(S[12], S[13]); p1.w = pk2(S[14], S[15]);
            const bf16x8 pa0 = __builtin_bit_cast(bf16x8, p0), pa1 = __builtin_bit_cast(bf16x8, p1);
#pragma unroll
            for (int pb = 0; pb < 2; ++pb) { O[pb] = MFMA32(vf[2 * pb], pa0, O[pb]); O[pb] = MFMA32(vf[2 * pb + 1], pa1, O[pb]); }
        }
        const float ei = __expf(lai);
        const int row = seq_row(b, dir, c * 256 + qi);
        bf16_t* yo = yssd + ((size_t)dir * MROWS + row) * 1024 + head * 64;
#pragma unroll
        for (int pb = 0; pb < 2; ++pb)
#pragma unroll
            for (int q = 0; q < 4; ++q) { f32x4 o;
#pragma unroll
                for (int e = 0; e < 4; ++e) o[e] = O[pb][4 * q + e] + ei * Oo[pb][4 * q + e];
                u32x2 w2; w2.x = pk2(o[0], o[1]); w2.y = pk2(o[2], o[3]); *(u32x2*)(yo + 32 * pb + 8 * q + 4 * hi) = w2; }
    }
}

__device__ __forceinline__ void s5_phase(const Args& a, int l, unsigned char* ldsb) {
    unsigned char* ws = a.ws;
    const bf16_t* P = (const bf16_t*)(ws + WS_P); bf16_t* ys5 = (bf16_t*)(ws + WS_YS5);
    const int tid = otid(), lane = tid & 63, w = tid >> 6, r32 = lane & 31, hi = lane >> 5;
    f32x2v* Eseg = (f32x2v*)ldsb;
    unsigned char* hb = ldsb + 16384 + w * 8704;
    const int hh = (r32 >> 2) & 1, rr = (r32 & 3) + 4 * (r32 >> 3), tl = 16 * hh + rr;
    const int mysg = 2 * w + hi;
    for (int u = obid(); u < 256; u += gridDim.x) {
        const int g = u & 63, dir = (u >> 6) & 1, b = u >> 7;
        float lbr[2], lbi[2], l16r[2], l16i[2]; bf16x8 bre[2], bim[2];
#pragma unroll
        for (int pbk = 0; pbk < 2; ++pbk) {
            const int p = 32 * pbk + r32;
            const size_t li = ((size_t)(l * 2 + dir) * 64 + g) * 64 + p;
            const float lre = a.in[19][li], lim = a.in[20][li];
            const float delta = __expf(a.in[21][(l * 2 + dir) * 64 + g]);
            const float er = __expf(lre * delta); float sn, cs; __sincosf(lim * delta, &sn, &cs);
            const float xr = er * cs, xi = er * sn; lbr[pbk] = xr; lbi[pbk] = xi;
            const float den = 1.f / (lre * lre + lim * lim);
            const float cr = ((xr - 1.f) * lre + xi * lim) * den, ci = (xi * lre - (xr - 1.f) * lim) * den;
            const float* bre_g = a.in[22] + (((size_t)l * 64 + g) * 64 + p) * 16 + 8 * hi; const float* bim_g = a.in[23] + (((size_t)l * 64 + g) * 64 + p) * 16 + 8 * hi;
            float fr[8], fi[8];
#pragma unroll
            for (int j = 0; j < 8; ++j) { const float x = bre_g[j], y = bim_g[j]; fr[j] = cr * x - ci * y; fi[j] = cr * y + ci * x; }
            u32x4 t; t.x = pk2(fr[0], fr[1]); t.y = pk2(fr[2], fr[3]); t.z = pk2(fr[4], fr[5]); t.w = pk2(fr[6], fr[7]); bre[pbk] = __builtin_bit_cast(bf16x8, t);
            t.x = pk2(fi[0], fi[1]); t.y = pk2(fi[2], fi[3]); t.z = pk2(fi[4], fi[5]); t.w = pk2(fi[6], fi[7]); bim[pbk] = __builtin_bit_cast(bf16x8, t);
            float pr_ = xr, pi_ = xi;
#pragma unroll
            for (int k = 0; k < 4; ++k) { const float nr = pr_ * pr_ - pi_ * pi_, ni = 2.f * pr_ * pi_; pr_ = nr; pi_ = ni; }
            l16r[pbk] = pr_; l16i[pbk] = pi_;
        }
        bf16x8 cA[8];
#pragma unroll
        for (int kk = 0; kk < 8; ++kk) {
            u32x4 t = (u32x4){0u, 0u, 0u, 0u};
            if (r32 < 16) { const size_t ci_ = (((size_t)l * 64 + g) * 16 + r32) * 64 + 8 * kk + 4 * hi;
                const f32x4 c4 = *(const f32x4*)(a.in[24] + ci_), d4 = *(const f32x4*)(a.in[25] + ci_);
                t.x = pk2(c4[0], -d4[0]); t.y = pk2(c4[1], -d4[1]); t.z = pk2(c4[2], -d4[2]); t.w = pk2(c4[3], -d4[3]); }
            cA[kk] = __builtin_bit_cast(bf16x8, t);
        }
        float Hcr[2] = {0.f, 0.f}, Hci[2] = {0.f, 0.f};
        u32x4 unext = *(const u32x4*)(P + (size_t)seq_row(b, dir, 32 * w + tl) * NINP + UOFF + g * 16 + 8 * hi);
        for (int tile = 0; tile < NCH; ++tile) {
            const u32x4 ucur = unext;
            if (tile + 1 < NCH) unext = *(const u32x4*)(P + (size_t)seq_row(b, dir, (tile + 1) * 256 + 32 * w + tl) * NINP + UOFF + g * 16 + 8 * hi);
            const bf16x8 uA = __builtin_bit_cast(bf16x8, ucur);
            f32x16 Dre[2], Dim[2]; f32x16 zero;
#pragma unroll
            for (int r = 0; r < 16; ++r) zero[r] = 0.f;
            f32x2v* Ew = Eseg + (tile & 1) * 1024;
#pragma unroll
            for (int pbk = 0; pbk < 2; ++pbk) {
                Dre[pbk] = MFMA32(uA, bre[pbk], zero); Dim[pbk] = MFMA32(uA, bim[pbk], zero);
                float hr = 0.f, hi_ = 0.f;
#pragma unroll
                for (int r = 0; r < 16; ++r) { const float nr = lbr[pbk] * hr - lbi[pbk] * hi_ + Dre[pbk][r], ni = lbr[pbk] * hi_ + lbi[pbk] * hr + Dim[pbk][r];
                    hr = nr; hi_ = ni; Dre[pbk][r] = hr; Dim[pbk][r] = hi_; }
                Ew[mysg * 64 + 32 * pbk + r32] = (f32x2v){hr, hi_};
            }
            __syncthreads();
#pragma unroll
            for (int pbk = 0; pbk < 2; ++pbk) {
                float cr_ = Hcr[pbk], ci2 = Hci[pbk], inr = 0.f, ini = 0.f;
#pragma unroll
                for (int sg = 0; sg < 16; ++sg) {
                    if (sg == mysg) { inr = cr_; ini = ci2; }
                    const f32x2v e = Ew[sg * 64 + 32 * pbk + r32];
                    const float nr = l16r[pbk] * cr_ - l16i[pbk] * ci2 + e.x, ni = l16r[pbk] * ci2 + l16i[pbk] * cr_ + e.y;
                    cr_ = nr; ci2 = ni;
                }
                Hcr[pbk] = cr_; Hci[pbk] = ci2;
#pragma unroll
                for (int r = 0; r < 16; ++r) { const float nr = lbr[pbk] * inr - lbi[pbk] * ini, ni = lbr[pbk] * ini + lbi[pbk] * inr; inr = nr; ini = ni;
                    *(unsigned*)(hb + (16 * hi + r) * 272 + 4 * (32 * pbk + r32)) = pk2(Dre[pbk][r] + inr, Dim[pbk][r] + ini); }
            }
            asm volatile("s_waitcnt lgkmcnt(0)" ::: "memory");
            f32x16 Y = zero;
#pragma unroll
            for (int kk = 0; kk < 8; ++kk) { const bf16x8 hB = *(const bf16x8*)(hb + r32 * 272 + 32 * kk + 16 * hi); Y = MFMA32(cA[kk], hB, Y); }
            const int row = seq_row(b, dir, tile * 256 + 32 * w + r32);
            bf16_t* yo = ys5 + ((size_t)dir * MROWS + row) * 1024 + g * 16 + 4 * hi;
            { u32x2 w2; w2.x = pk2(Y[0], Y[1]); w2.y = pk2(Y[2], Y[3]); *(u32x2*)yo = w2; w2.x = pk2(Y[4], Y[5]); w2.y = pk2(Y[6], Y[7]); *(u32x2*)(yo + 8) = w2; }
            asm volatile("s_waitcnt lgkmcnt(0)" ::: "memory");
        }
        __syncthreads();
    }
}

__device__ __forceinline__ float gelu_tanh(float x) { const float t = 0.7978845608028654f * (x + 0.044715f * x * x * x); const float e = __expf(2.f * t); const float th = 1.f - 2.f / (e + 1.f); return 0.5f * x * (1.f + th); }
__device__ __forceinline__ void post_phase(const Args& a, int l, int nrows) {
    unsigned char* ws = a.ws;
    const bf16_t* P = (const bf16_t*)(ws + WS_P); const float* xbc = (const float*)(ws + WS_XBC);
    const bf16_t* yssd = (const bf16_t*)(ws + WS_YSSD); const bf16_t* ys5 = (const bf16_t*)(ws + WS_YS5);
    bf16_t* s5g = (bf16_t*)(ws + WS_AST); bf16_t* yss = (bf16_t*)(ws + WS_AST) + (size_t)2 * MROWS * 1024;
    const float* dssd = a.in[17] + l * 16; const float* gn = a.in[18] + l * 1024; const float* ds5 = a.in[26] + l * 1024;
    const int tid = otid(), lane = tid & 63, wave = tid >> 6;
    const int gw = obid() * NWAVES + wave, NGW = gridDim.x * NWAVES;
    for (int row = gw; row < nrows; row += NGW) {
        float v[2][8]; float ss = 0.f;
#pragma unroll
        for (int k = 0; k < 2; ++k) { const int ch = 8 * lane + 512 * k; const float dd = dssd[ch >> 6];
            const u32x4 zw = *(const u32x4*)(P + (size_t)row * NINP + ZOFF + ch); float z[8]; unpack8(zw, z);
            float yf[8], yb[8]; unpack8(*(const u32x4*)(yssd + (size_t)row * 1024 + ch), yf); unpack8(*(const u32x4*)(yssd + ((size_t)MROWS + row) * 1024 + ch), yb);
#pragma unroll
            for (int q = 0; q < 2; ++q) { const f32x4 xv = *(const f32x4*)(xbc + (size_t)row * 1536 + ch + 4 * q);
#pragma unroll
                for (int j = 0; j < 4; ++j) { const float y = (yf[4 * q + j] + yb[4 * q + j] + dd * xv[j]) * siluf_(z[4 * q + j]); v[k][4 * q + j] = y; ss += y * y; } } }
        const float rstd = rsqrtf(wave_sum(ss) * (1.f / 1024.f) + EPS);
#pragma unroll
        for (int k = 0; k < 2; ++k) { const int ch = 8 * lane + 512 * k; const f32x4 g0 = *(const f32x4*)(gn + ch), g1 = *(const f32x4*)(gn + ch + 4);
            u32x4 w; w.x = pk2(v[k][0] * rstd * g0[0], v[k][1] * rstd * g0[1]); w.y = pk2(v[k][2] * rstd * g0[2], v[k][3] * rstd * g0[3]);
            w.z = pk2(v[k][4] * rstd * g1[0], v[k][5] * rstd * g1[1]); w.w = pk2(v[k][6] * rstd * g1[2], v[k][7] * rstd * g1[3]);
            *(u32x4*)(yss + (size_t)row * 1024 + ch) = w; }
#pragma unroll
        for (int k = 0; k < 2; ++k) { const int ch = 8 * lane + 512 * k;
            const u32x4 uw = *(const u32x4*)(P + (size_t)row * NINP + UOFF + ch); float uu[8]; unpack8(uw, uu); float o[8];
            float yf[8], yb[8]; unpack8(*(const u32x4*)(ys5 + (size_t)row * 1024 + ch), yf); unpack8(*(const u32x4*)(ys5 + ((size_t)MROWS + row) * 1024 + ch), yb);
#pragma unroll
            for (int q = 0; q < 2; ++q) { const f32x4 dv = *(const f32x4*)(ds5 + ch + 4 * q);
#pragma unroll
                for (int j = 0; j < 4; ++j) o[4 * q + j] = gelu_tanh(yf[4 * q + j] + yb[4 * q + j] + dv[j] * uu[4 * q + j]); }
            u32x4 w; w.x = pk2(o[0], o[1]); w.y = pk2(o[2], o[3]); w.z = pk2(o[4], o[5]); w.w = pk2(o[6], o[7]);
            *(u32x4*)(s5g + (size_t)row * 1024 + ch) = w; }
    }
}

#define LAS __attribute__((address_space(3)))
#define XB_TMO      128
#define XB_XCNT(j)  (256  + 64 * (j))
#define XB_XSUB(j)  (1280 + 64 * (j))
#define XB_XGEN(j)  (2304 + 64 * (j))
#define XB_TOP      3328
#define XB_TOPGEN   3392
#define XCD_BAR_WORDS 3456
#define XB_SPIN_CAP (1u << 20)
__device__ __forceinline__ unsigned xb_ld(unsigned* p)              { return __hip_atomic_load(p, __ATOMIC_RELAXED, __HIP_MEMORY_SCOPE_AGENT); }
__device__ __forceinline__ unsigned xb_add(unsigned* p, unsigned v) { return __hip_atomic_fetch_add(p, v, __ATOMIC_RELAXED, __HIP_MEMORY_SCOPE_AGENT); }
__device__ __forceinline__ unsigned xb_xcc_id() { return (unsigned)__builtin_amdgcn_s_getreg((3 << 11) | 20) & 0xFu; }
#define XB_SPIN(cond, bar) do { unsigned _sp = 0; while (cond) { __builtin_amdgcn_s_sleep(1); \
    if ((++_sp & 255u) == 0u) { if (xb_ld(&(bar)[XB_TMO])) break; if (_sp > XB_SPIN_CAP) { atomicAdd(&(bar)[XB_TMO], 1u); break; } } } } while (0)
struct XcdBarrier { unsigned* bar; unsigned x; volatile LAS unsigned* st; };
__device__ __forceinline__ XcdBarrier xcd_barrier_post(unsigned* bar, volatile LAS unsigned* st) {
    XcdBarrier b; b.bar = bar; b.x = xb_xcc_id(); b.st = st;
    if (threadIdx.x == 0) (void)xb_add(&bar[XB_XCNT(b.x)], 1u);
    return b;
}
__device__ __forceinline__ void xcd_barrier_complete(unsigned* bar, unsigned x, unsigned& nloc, unsigned& nx) {
    const unsigned G = gridDim.x * gridDim.y * gridDim.z;
    unsigned sum, cnt, mine, sp = 0u;
    for (;;) {
        sum = 0u; cnt = 0u; mine = 0u;
#pragma unroll
        for (unsigned j = 0; j < 16; ++j) { const unsigned c = xb_ld(&bar[XB_XCNT(j)]); sum += c; cnt += (c > 0u) ? 1u : 0u; mine = (j == x) ? c : mine; }
        if (sum == G) break;
        __builtin_amdgcn_s_sleep(1);
        if ((++sp & 255u) == 0u) { if (xb_ld(&bar[XB_TMO])) break; if (sp > XB_SPIN_CAP) { atomicAdd(&bar[XB_TMO], 1u); break; } }
    }
    nloc = mine > 0u ? mine : 1u; nx = cnt > 0u ? cnt : 1u;
}
__device__ __forceinline__ void xcd_barrier(const XcdBarrier& b) {
    asm volatile("s_waitcnt vmcnt(0)" ::: "memory");
    __syncthreads();
    if (threadIdx.x == 0) {
        unsigned* bar = b.bar;
        __builtin_amdgcn_s_waitcnt(0);
        unsigned nloc = b.st[0], nx = b.st[1];
        if (nloc == 0u) { xcd_barrier_complete(bar, b.x, nloc, nx); b.st[0] = nloc; b.st[1] = nx; }
        const unsigned old = xb_add(&bar[XB_XSUB(b.x)], 1u);
        const unsigned gen = old / nloc;
        if (old + 1u == (gen + 1u) * nloc) {
            __builtin_amdgcn_fence(__ATOMIC_RELEASE, "agent");
            asm volatile("s_waitcnt vmcnt(0)" ::: "memory");
            const unsigned og = xb_add(&bar[XB_TOP], 1u);
            const unsigned tg = og / nx;
            if (og + 1u == (tg + 1u) * nx) xb_add(&bar[XB_TOPGEN], 1u);
            else XB_SPIN(xb_ld(&bar[XB_TOPGEN]) == tg, bar);
            __builtin_amdgcn_fence(__ATOMIC_ACQUIRE, "agent");
            xb_add(&bar[XB_XGEN(b.x)], 1u);
            asm volatile("s_waitcnt vmcnt(0)" ::: "memory");
        } else {
            XB_SPIN(xb_ld(&bar[XB_XGEN(b.x)]) == gen, bar);
            __builtin_amdgcn_fence(__ATOMIC_ACQUIRE, "agent");
            asm volatile("s_waitcnt vmcnt(0)" ::: "memory");
        }
    }
    __syncthreads();
}

__global__ void __launch_bounds__(NT, 2) mega(Args a) {
    extern __shared__ __attribute__((aligned(16))) unsigned char lds[];
    cg::grid_group grid = cg::this_grid();
    PG8_LAS unsigned char* glds = (PG8_LAS unsigned char*)lds;
    float* fl = (float*)lds;
    unsigned char* ws = a.ws;
    float* modv = (float*)(ws + WS_MOD);
    float* xc = (float*)(ws + WS_XC);
    bf16_t* H = (bf16_t*)(ws + WS_H); bf16_t* P = (bf16_t*)(ws + WS_P); bf16_t* HFF = (bf16_t*)(ws + WS_P);
    bf16_t* AST = (bf16_t*)(ws + WS_AST);
    bf16_t* BR0 = (bf16_t*)(ws + WS_BR0); bf16_t* BR1 = (bf16_t*)(ws + WS_BR1); bf16_t* MRG = (bf16_t*)(ws + WS_MRG);
    bf16_t* OBH = (bf16_t*)(ws + WS_O);
    const int G = gridDim.x, bx = obid();
    volatile LAS unsigned* bst = (volatile LAS unsigned*)((LAS unsigned char*)lds + (LDS_BYTES - 16));
    if (threadIdx.x == 0) { bst[0] = 0u; bst[1] = 0u; }
    __syncthreads();
    (void)xcd_barrier_post((unsigned*)(ws + WS_BAR), bst);
#define GSYNC() do { XcdBarrier xb_; xb_.bar = (unsigned*)(a.ws + WS_BAR); xb_.x = xb_xcc_id(); xb_.st = (volatile LAS unsigned*)((LAS unsigned char*)lds + (LDS_BYTES - 16)); xcd_barrier(xb_); } while (0)

    mod_phase(a, fl, modv, 0, 128, G);
    __syncthreads();
    wconv_phase(a, 0, fl, 1, 0);
    if (a.ws == nullptr) grid.sync();
    GSYNC();
    if (PROBE_DUP == 9) { for (int i = 0; i < 20; ++i) GSYNC(); }
    { RowPass rp{}; rp.src_lat = a.in[0]; rp.src_ctx = a.in[2]; rp.dst_lat = nullptr; rp.dst_ctx = nullptr; rp.o = nullptr;
      rp.h = H; rp.gpre = a.in[6]; rp.shv = modv + 0 * 2048; rp.scv = modv + 1 * 2048; rp.nrows = MROWS; row_pass(rp); }
    GSYNC();

    for (int l = 0; l < 2; ++l) {
        const bool last = (l == 1);
        const int mact = last ? MLAT : MROWS;
        const float* modl = modv + (size_t)l * 3 * 12288;
        { pg8::Gemm g{H, (const bf16_t*)(ws + WS_WIN), MROWS, NINP, D}; pg8::StaticOrder S; S.init(MROWS, NINP, G, bx);
          EpiStore16 E{P, NINP}; pg8::gemm_phase<EpiStore16, pg8::StaticOrder, true, true>(glds, g, S, E); }
        GSYNC();
        prep_phase(a, l, fl);
        la_phase(a, l);
        if (PROBE_DUP == 4) prep_phase(a, l, fl);
        GSYNC();
        prep2_phase(a, fl);
        GSYNC();
        ssd_state_phase(a, fl);
        __syncthreads();
        attn_phase(a, l, !last, lds);
        if (!last) { const int nfill = (G >= 128) ? G - 64 : G; __syncthreads(); wconv_phase(a, 0, fl, 2 | 4 | 8 | 16, 0, nfill); __syncthreads(); mod_phase(a, fl, modv, 128, 256, nfill); }
        if (PROBE_DUP == 1) { __syncthreads(); attn_phase(a, l, !last, lds); }
        if (PROBE_DUP == 2) { __syncthreads(); ssd_state_phase(a, fl); }
        GSYNC();
        s5_phase(a, l, lds);
        __syncthreads();
        ssd_out_phase(a, lds, last ? 1 : 0);
        if (PROBE_DUP == 2) { __syncthreads(); ssd_out_phase(a, lds, last ? 1 : 0); }
        if (PROBE_DUP == 3) { __syncthreads(); s5_phase(a, l, lds); }
        GSYNC();
        post_phase(a, l, mact);
        if (PROBE_DUP == 4) post_phase(a, l, mact);
        GSYNC();
        { pg8::Gemm g{AST, (const bf16_t*)(ws + WS_WSTK), mact, 2048, 1024}; pg8::MultiOrder S; S.init(mact, 2048, 3, MT, G, bx);
          EpiG1 E{AST + (size_t)3 * MROWS * 1024, a.in[28] + l * 2048, BR0, BR1, P}; pg8::gemm_phase<EpiG1, pg8::MultiOrder, true, true>(glds, g, S, E); }
        GSYNC();
        { pg8::Gemm g{AST + (size_t)3 * MROWS * 1024, (const bf16_t*)(ws + WS_WSTK) + (size_t)3 * 2048 * 1024, mact, 2048, 1024}; pg8::StaticOrder S; S.init(mact, 2048, G, bx);
          EpiG2 E{MRG, BR0, BR1, P}; pg8::gemm_phase<EpiG2, pg8::StaticOrder, true, true>(glds, g, S, E); }
        if (!last) { __syncthreads(); wconv_phase(a, 1, fl, 32, 16); }
        GSYNC();
        { pg8::Gemm g{MRG, (const bf16_t*)(ws + WS_WOUT), mact, 2048, 2048}; pg8::StaticOrder S; S.init(mact, 2048, G, bx);
          EpiStore16 E{OBH, D}; pg8::gemm_phase<EpiStore16, pg8::StaticOrder, true, true>(glds, g, S, E); }
        if (!last) { __syncthreads(); wconv_phase(a, 1, fl, 64, 16); }
        GSYNC();
        { RowPass rp{}; rp.src_lat = (l == 0) ? a.in[0] : a.out; rp.src_ctx = (l == 0) ? a.in[2] : xc; rp.dst_lat = a.out; rp.dst_ctx = xc; rp.o = OBH; rp.gpost = a.in[7] + l * D; rp.gatev = modl + 2 * 2048;
          rp.h = H; rp.gpre = a.in[8] + l * D; rp.shv = modl + 3 * 2048; rp.scv = modl + 4 * 2048; rp.nrows = mact; row_pass(rp); }
        GSYNC();
        { pg8::Gemm g{H, (const bf16_t*)(ws + WS_WGU), mact, 2 * DFF, D}; pg8::StaticOrder S; S.init(mact, 2 * DFF, G, bx);
          EpiPair<0> E{HFF, DFF, nullptr}; pg8::gemm_phase<EpiPair<0>, pg8::StaticOrder, true, true>(glds, g, S, E); }
        GSYNC();
        { pg8::Gemm g{HFF, (const bf16_t*)(ws + WS_WDN), mact, 2048, DFF}; pg8::StaticOrder S; S.init(mact, 2048, G, bx);
          EpiStore16 E{OBH, D}; pg8::gemm_phase<EpiStore16, pg8::StaticOrder, true, true>(glds, g, S, E); }
        if (!last) { __syncthreads(); wconv_phase(a, 1, fl, 2 | 4 | 8, 16); }
        GSYNC();
        { RowPass rp{}; rp.src_lat = a.out; rp.src_ctx = xc; rp.dst_lat = a.out; rp.dst_ctx = xc; rp.o = OBH; rp.gpost = a.in[9] + l * D; rp.gatev = modl + 5 * 2048;
          if (!last) { rp.h = H; rp.gpre = a.in[6] + D; rp.shv = modv + (size_t)3 * 12288 + 0 * 2048; rp.scv = modv + (size_t)3 * 12288 + 1 * 2048; }
          rp.nrows = mact; row_pass(rp); }
        if (!last) { __syncthreads(); wconv_phase(a, 1, fl, 16, 0); GSYNC(); }
    }
}

extern "C" void kernel_launch(void* const* d_in, const int* in_sizes, int n_in, void* d_out, int out_size, void* d_ws, size_t ws_size, hipStream_t stream) {
    static int grid_blocks = 0;
    if (!grid_blocks) {
        int dev = 0, cus = 0, per_cu = 0;
        (void)hipGetDevice(&dev);
        (void)hipDeviceGetAttribute(&cus, hipDeviceAttributeMultiprocessorCount, dev);
        (void)hipFuncSetAttribute((const void*)mega, hipFuncAttributeMaxDynamicSharedMemorySize, LDS_BYTES);
        (void)hipOccupancyMaxActiveBlocksPerMultiprocessor(&per_cu, (const void*)mega, NT, LDS_BYTES);
        if (per_cu < 1) per_cu = 1;
        if (per_cu > 1) per_cu = 1;
        grid_blocks = cus * per_cu;
        if (ws_size < WS_END) fprintf(stderr, "kernel_launch: workspace too small: %zu < %zu\n", ws_size, (size_t)WS_END);
    }
    (void)hipMemsetAsync((unsigned char*)d_ws + WS_BAR, 0, WS_BAR_BYTES, stream);
    Args a{};
    for (int i = 0; i < 34; ++i) a.in[i] = (const float*)d_in[i];
    a.out = (float*)d_out; a.ws = (unsigned char*)d_ws;
    void* args[] = {&a};
    hipError_t e = hipLaunchCooperativeKernel((void*)mega, dim3(grid_blocks), dim3(NT), args, LDS_BYTES, stream);
    if (e != hipSuccess) fprintf(stderr, "cooperative launch failed: %s (grid %d)\n", hipGetErrorString(e), grid_blocks);
}
```

```cpp
#include <hip/hip_runtime.h>
#include <hip/hip_cooperative_groups.h>
#include <cstdio>
#include <cstdint>
namespace cg = cooperative_groups;

__device__ __forceinline__ int otid() { int t = threadIdx.x; asm volatile("" : "+v"(t)); return t; }
__device__ __forceinline__ int obid() { int t = blockIdx.x; asm volatile("" : "+s"(t)); return t; }
namespace pg8 {
#define PG8_LAS __attribute__((address_space(3)))
typedef unsigned short bf16_t;
typedef short bf16x8 __attribute__((ext_vector_type(8)));
typedef float f32x4 __attribute__((ext_vector_type(4)));
typedef unsigned u32x4 __attribute__((ext_vector_type(4)));
constexpr int BM = 256, BK = 64, HALF = 128, HTB = HALF * BK * 2, STAGE_BYTES = 8 * HTB, NXCD = 8, WGM = 4;

__host__ __device__ __forceinline__ int lds_byte(int r, int c) { const int st = (r >> 4) * 2 + (c >> 5), rr = r & 15, cc = c & 31, ob = rr * 64 + cc * 2; return st * 1024 + (ob ^ (((ob >> 9) & 1) << 5)); }
__host__ __device__ __forceinline__ void stage_rc(int b, int& R, int& C) { const int st = b / 1024, sb = b % 1024, swz = sb ^ (((sb >> 9) & 1) << 5); R = (st >> 1) * 16 + swz / 64; C = (st & 1) * 32 + (swz % 64) / 2; }
__host__ __device__ __forceinline__ int perm32(int rho) { const int n = rho >> 4, i = rho & 15; return 8 * (i >> 2) + 4 * n + (i & 3); }

struct Unit { int pm, pn; };
struct Gemm { const bf16_t* A; const bf16_t* Bt; int M, N, K; };

struct StaticOrder {
    int nM, nN, nwg, G, c;
    __host__ __device__ void init(int M, int N, int G_, int c_) { nM = M / BM; nN = N / BM; nwg = nM * nN; G = G_; c = c_; }
    __host__ __device__ bool next(int i, Unit& u) const {
        const long L = (long)i * G + c; if (L >= nwg) return false;
        int wgid = (int)L; { const int q = nwg / NXCD, r = nwg % NXCD, xcd = wgid % NXCD, off = wgid / NXCD; wgid = (xcd < r ? xcd * (q + 1) : r * (q + 1) + (xcd - r) * q) + off; }
        const int nig = WGM * nN, gid = wgid / nig, fm = gid * WGM, gsz = (nM - fm) < WGM ? (nM - fm) : WGM;
        u.pm = fm + ((wgid % nig) % gsz); u.pn = (wgid % nig) / gsz; return true;
    }
    __device__ __forceinline__ void a_ready(const Unit&) const {}
    __device__ __forceinline__ void done(const Unit&) const {}
};
struct MultiOrder {
    StaticOrder so; int nN1, mstride;
    __host__ __device__ void init(int M, int N1, int ng, int mstride_, int G_, int c_) { so.init(M, N1 * ng, G_, c_); nN1 = N1 / BM; mstride = mstride_; }
    __host__ __device__ bool next(int i, Unit& u) const { if (!so.next(i, u)) return false; const int gi = u.pn / nN1; u.pm += gi * mstride; return true; }
    __device__ __forceinline__ void a_ready(const Unit&) const {}
    __device__ __forceinline__ void done(const Unit&) const {}
};

typedef float f32x2 __attribute__((ext_vector_type(2)));
typedef __bf16 bf16x2_t __attribute__((ext_vector_type(2)));
__device__ __forceinline__ unsigned cvt_pk_bf16(float lo, float hi) { f32x2 v = {lo, hi}; bf16x2_t b = __builtin_convertvector(v, bf16x2_t); return __builtin_bit_cast(unsigned, b); }

template <class Epi, class Sched, bool ALIGN_EPI = false, bool SP2 = false>
__device__ __forceinline__ void gemm_phase(PG8_LAS unsigned char* lds, const Gemm g, const Sched& S, const Epi& E) {
    const int tid = otid(), wid = __builtin_amdgcn_readfirstlane(tid >> 6), lane = tid & 63, wr = wid >> 2, wc = wid & 3, fr = lane & 15, fq = lane >> 4;
    const int K = g.K, nt = K / BK;
    unsigned voffA[2], voffB[2];
#pragma unroll
    for (int i = 0; i < 2; ++i) { int R, C; stage_rc(tid * 16 + i * 8192, R, C); const int Rb = Epi::PERM ? ((R & ~31) + perm32(R & 31)) : R;
        voffA[i] = (unsigned)(R * K + C) * 2u; voffB[i] = (unsigned)(Rb * K + C) * 2u; }
    const size_t kstep = (size_t)(BK * 2);
    const size_t hstep = (size_t)HALF * K * 2;
    const size_t tstep = 2 * hstep;
    const unsigned ldsw = (unsigned)wid * 1024u;
    const int aoff = lds_byte(wr * 64 + fr, fq * 8), boff = lds_byte(wc * 32 + fr, fq * 8);
#define PG8_SA(b, h) (((b) * 2 + (h)) * HTB)
#define PG8_SB(b, h) ((4 + (b) * 2 + (h)) * HTB)
#define PG8_STAGE(bufoff, gbase, voff) do { _Pragma("unroll") for (int _i = 0; _i < 2; ++_i) \
        __builtin_amdgcn_global_load_lds((const unsigned*)((const char*)(gbase) + (voff)[_i]), (PG8_LAS unsigned*)(lds + (bufoff) + ldsw + _i * 8192), 16, 0, 0); } while (0)
#define PG8_LDA(dst, b, h) do { _Pragma("unroll") for (int m = 0; m < 4; ++m) _Pragma("unroll") for (int k = 0; k < 2; ++k) dst[m][k] = *(const PG8_LAS bf16x8*)(lds + PG8_SA(b, h) + aoff + m * 2048 + k * 1024); } while (0)
#define PG8_LDB(dst, b, h) do { _Pragma("unroll") for (int n = 0; n < 2; ++n) _Pragma("unroll") for (int k = 0; k < 2; ++k) dst[n][k] = *(const PG8_LAS bf16x8*)(lds + PG8_SB(b, h) + boff + n * 2048 + k * 1024); } while (0)
#define PG8_MMA(ai, bj, At, Bt) do { __builtin_amdgcn_s_setprio(1); _Pragma("unroll") for (int m = 0; m < 4; ++m) _Pragma("unroll") for (int n = 0; n < 2; ++n) _Pragma("unroll") for (int k = 0; k < 2; ++k) \
        acc[ai][bj][m][n] = __builtin_amdgcn_mfma_f32_16x16x32_bf16(Bt[n][k], At[m][k], acc[ai][bj][m][n], 0, 0, 0); __builtin_amdgcn_s_setprio(0); } while (0)
#define PG8_WAIT_V(n) asm volatile("s_waitcnt vmcnt(" #n ")" ::: "memory")
#define PG8_WAIT_L(n) asm volatile("s_waitcnt lgkmcnt(" #n ")" ::: "memory")
#define PG8_BAR __builtin_amdgcn_s_barrier()
#define PG8_SCHED __builtin_amdgcn_sched_barrier(0)
    Unit cur, nxt; int ui = 0;
    if (!S.next(0, cur)) return;
    f32x4 acc[2][2][4][2];
#pragma unroll
    for (int a = 0; a < 2; ++a)
#pragma unroll
        for (int b = 0; b < 2; ++b)
#pragma unroll
            for (int m = 0; m < 4; ++m)
#pragma unroll
                for (int n = 0; n < 2; ++n) acc[a][b][m][n] = (f32x4){0.f, 0.f, 0.f, 0.f};
    bf16x8 At[4][2], B0[2][2], B1[2][2];
    const char* cA = (const char*)g.A + (size_t)cur.pm * tstep; const char* cB = (const char*)g.Bt + (size_t)cur.pn * tstep;
    S.a_ready(cur);
    if constexpr (SP2) {
        PG8_STAGE(PG8_SB(0, 0), cB, voffB); PG8_STAGE(PG8_SB(0, 1), cB + hstep, voffB); PG8_STAGE(PG8_SA(0, 0), cA, voffA); PG8_STAGE(PG8_SA(0, 1), cA + hstep, voffA);
        if (wr == 1) PG8_BAR;
        PG8_WAIT_V(2); PG8_BAR;
        PG8_STAGE(PG8_SB(1, 0), cB + kstep, voffB); PG8_STAGE(PG8_SA(1, 0), cA + kstep, voffA); PG8_STAGE(PG8_SB(1, 1), cB + hstep + kstep, voffB);
        PG8_WAIT_V(6); PG8_BAR;
    } else {
        PG8_STAGE(PG8_SB(0, 0), cB, voffB); PG8_STAGE(PG8_SA(0, 0), cA, voffA); PG8_STAGE(PG8_SB(0, 1), cB + hstep, voffB); PG8_STAGE(PG8_SA(0, 1), cA + hstep, voffA);
        if (wr == 1) PG8_BAR;
        PG8_WAIT_V(4); PG8_BAR;
        PG8_STAGE(PG8_SB(1, 0), cB + kstep, voffB); PG8_STAGE(PG8_SA(1, 0), cA + kstep, voffA); PG8_STAGE(PG8_SB(1, 1), cB + hstep + kstep, voffB);
        PG8_WAIT_V(6); PG8_BAR;
    }
    for (;;) {
        const bool has_next = S.next(ui + 1, nxt);
        const char* nA = has_next ? (const char*)g.A + (size_t)nxt.pm * tstep : cA; const char* nB = has_next ? (const char*)g.Bt + (size_t)nxt.pn * tstep : cB;
        for (int t = 0; t < nt; t += 2) {
            const bool last = (t == nt - 2);
            const char* a1 = cA + (size_t)(t + 1) * kstep;
            const char* a2 = last ? nA : cA + (size_t)(t + 2) * kstep; const char* b2 = last ? nB : cB + (size_t)(t + 2) * kstep;
            const char* a3 = a2 + kstep; const char* b3 = b2 + kstep;
            if (last && has_next) S.a_ready(nxt);
            if constexpr (SP2) {
            PG8_LDB(B0, 0, 0); PG8_LDB(B1, 0, 1); PG8_SCHED; PG8_LDA(At, 0, 0); PG8_STAGE(PG8_SA(1, 1), a1 + hstep, voffA);
            PG8_WAIT_V(8); PG8_WAIT_L(0); PG8_BAR; PG8_MMA(0, 0, At, B0); PG8_MMA(0, 1, At, B1); PG8_BAR; PG8_SCHED;
            PG8_LDA(At, 0, 1); PG8_STAGE(PG8_SB(0, 0), b2, voffB); PG8_STAGE(PG8_SB(0, 1), b2 + hstep, voffB); PG8_STAGE(PG8_SA(0, 0), a2, voffA);
            PG8_WAIT_V(8); PG8_WAIT_L(0); PG8_BAR; PG8_MMA(1, 0, At, B0); PG8_MMA(1, 1, At, B1); PG8_BAR; PG8_SCHED;
            PG8_LDB(B0, 1, 0); PG8_LDB(B1, 1, 1); PG8_SCHED; PG8_LDA(At, 1, 0); PG8_STAGE(PG8_SA(0, 1), a2 + hstep, voffA);
            PG8_WAIT_V(8); PG8_WAIT_L(0); PG8_BAR; PG8_MMA(0, 0, At, B0); PG8_MMA(0, 1, At, B1); PG8_BAR; PG8_SCHED;
            PG8_LDA(At, 1, 1); PG8_STAGE(PG8_SB(1, 0), b3, voffB); PG8_STAGE(PG8_SB(1, 1), b3 + hstep, voffB); PG8_STAGE(PG8_SA(1, 0), a3, voffA);
            PG8_WAIT_V(8); PG8_WAIT_L(0); PG8_BAR; PG8_MMA(1, 0, At, B0); PG8_MMA(1, 1, At, B1); PG8_BAR; PG8_SCHED;
            } else {
            PG8_LDB(B0, 0, 0); PG8_SCHED; PG8_LDA(At, 0, 0); PG8_STAGE(PG8_SA(1, 1), a1 + hstep, voffA);
            PG8_WAIT_L(8); PG8_BAR; PG8_WAIT_L(0); PG8_MMA(0, 0, At, B0); PG8_BAR; PG8_SCHED;
            PG8_LDB(B1, 0, 1); PG8_STAGE(PG8_SB(0, 0), b2, voffB);
            PG8_BAR; PG8_WAIT_L(0); PG8_MMA(0, 1, At, B1); PG8_BAR;
            PG8_LDA(At, 0, 1); PG8_STAGE(PG8_SA(0, 0), a2, voffA);
            PG8_BAR; PG8_WAIT_L(0); PG8_MMA(1, 0, At, B0); PG8_BAR; PG8_SCHED;
            PG8_STAGE(PG8_SB(0, 1), b2 + hstep, voffB);
            PG8_WAIT_V(6); PG8_BAR; PG8_MMA(1, 1, At, B1); PG8_BAR;
            PG8_LDB(B0, 1, 0); PG8_SCHED; PG8_LDA(At, 1, 0); PG8_STAGE(PG8_SA(0, 1), a2 + hstep, voffA);
            PG8_WAIT_L(8); PG8_BAR; PG8_WAIT_L(0); PG8_MMA(0, 0, At, B0); PG8_BAR; PG8_SCHED;
            PG8_LDB(B1, 1, 1); PG8_STAGE(PG8_SB(1, 0), b3, voffB);
            PG8_BAR; PG8_WAIT_L(0); PG8_MMA(0, 1, At, B1); PG8_BAR;
            PG8_LDA(At, 1, 1); PG8_STAGE(PG8_SA(1, 0), a3, voffA);
            PG8_BAR; PG8_WAIT_L(0); PG8_MMA(1, 0, At, B0); PG8_BAR; PG8_SCHED;
            PG8_STAGE(PG8_SB(1, 1), b3 + hstep, voffB);
            PG8_WAIT_V(6); PG8_BAR; PG8_MMA(1, 1, At, B1); PG8_BAR;
            }
        }
        if constexpr (ALIGN_EPI) { if (wr == 0) PG8_BAR; }
        E(acc, cur, wr, wc, fr, fq); S.done(cur);
        if (!has_next) break;
#pragma unroll
        for (int a = 0; a < 2; ++a)
#pragma unroll
            for (int b = 0; b < 2; ++b)
#pragma unroll
                for (int m = 0; m < 4; ++m)
#pragma unroll
                    for (int n = 0; n < 2; ++n) acc[a][b][m][n] = (f32x4){0.f, 0.f, 0.f, 0.f};
        cur = nxt; cA = nA; cB = nB; ++ui;
        if constexpr (ALIGN_EPI) { if (wr == 1) PG8_BAR; }
    }
    PG8_WAIT_V(0);
    if constexpr (!ALIGN_EPI) { if (wr == 0) PG8_BAR; }
    PG8_BAR;
#undef PG8_SA
#undef PG8_SB
#undef PG8_STAGE
#undef PG8_LDA
#undef PG8_LDB
#undef PG8_MMA
#undef PG8_WAIT_V
#undef PG8_WAIT_L
#undef PG8_BAR
#undef PG8_SCHED
}
}

using pg8::bf16_t; using pg8::f32x4; using pg8::u32x4; using pg8::bf16x8;
typedef float f32x16 __attribute__((ext_vector_type(16)));
typedef float f32x2v __attribute__((ext_vector_type(2)));
typedef unsigned u32x2 __attribute__((ext_vector_type(2)));
constexpr int D = 2048, SEQ = 4096, CTXL = 256, MLAT = 8192, MCTX = 512, MROWS = 8704, MT = 34;
constexpr int NIN = 12832, NINP = 13056;
constexpr int QOFF = 0, KOFF = 1024, VOFF = 2048, ZOFF = 3072, XBCOFF = 4096, DTOFF = 5632, UOFF = 5664, GATEOFF = 6688;
constexpr int DFF = 5632, KVL = 4352, NCH = 17;
constexpr float EPS = 1e-6f;
constexpr int NT = 512, NWAVES = 8;
constexpr int LDS_BYTES = 147456;
#ifndef PROBE_DUP
#define PROBE_DUP 0
#endif

constexpr size_t MiB = 1u << 20;
constexpr size_t WS_WIN = 0;
constexpr size_t WS_WSTK = 51 * MiB;
constexpr size_t WS_WOUT = 67 * MiB;
constexpr size_t WS_WGU = 75 * MiB;
constexpr size_t WS_WDN = 119 * MiB;
constexpr size_t WS_P = 141 * MiB;
constexpr size_t WS_H = 358 * MiB;
constexpr size_t WS_XC = 392 * MiB;
constexpr size_t WS_AST = 396 * MiB;
constexpr size_t WS_DTV = 464 * MiB;
constexpr size_t WS_MOD = 467 * MiB;
constexpr size_t WS_R2 = 468 * MiB;
constexpr size_t WS_QR = WS_R2;
constexpr size_t WS_KR = WS_R2 + 17 * MiB;
constexpr size_t WS_VT = WS_R2 + 34 * MiB;
constexpr size_t WS_XBC = WS_R2 + 51 * MiB;
constexpr size_t WS_YSSD = WS_R2 + 102 * MiB;
constexpr size_t WS_YS5 = WS_R2 + 170 * MiB;
constexpr size_t WS_HINB = WS_R2 + 238 * MiB;
constexpr size_t WS_LA = WS_R2 + 255 * MiB;
constexpr size_t WS_BN = WS_R2 + 257 * MiB;
constexpr size_t WS_CN = WS_R2 + 266 * MiB;
constexpr size_t WS_BT = WS_R2 + 275 * MiB;
constexpr size_t WS_XDT = WS_R2 + 284 * MiB;
constexpr size_t WS_BR0 = WS_R2;
constexpr size_t WS_BR1 = WS_R2 + 34 * MiB;
constexpr size_t WS_MRG = WS_R2 + 68 * MiB;
constexpr size_t WS_O = WS_R2 + 102 * MiB;
constexpr size_t WS_BAR = WS_R2 + 318 * MiB;
constexpr size_t WS_BAR_BYTES = 16384;
constexpr size_t WS_END = WS_BAR + 1 * MiB;

struct Args { const float* in[34]; float* out; unsigned char* ws; };

__device__ __forceinline__ float bf2f(unsigned v) { return __uint_as_float(v << 16); }
__device__ __forceinline__ unsigned pk2(float lo, float hi) { return pg8::cvt_pk_bf16(lo, hi); }
__device__ __forceinline__ void unpack8(const u32x4 w, float* f) {
    f[0] = __uint_as_float(w.x << 16); f[1] = __uint_as_float(w.x & 0xffff0000u); f[2] = __uint_as_float(w.y << 16); f[3] = __uint_as_float(w.y & 0xffff0000u);
    f[4] = __uint_as_float(w.z << 16); f[5] = __uint_as_float(w.z & 0xffff0000u); f[6] = __uint_as_float(w.w << 16); f[7] = __uint_as_float(w.w & 0xffff0000u);
}
__device__ __forceinline__ float sigmoidf_(float x) { return 1.f / (1.f + __expf(-x)); }
__device__ __forceinline__ float siluf_(float x) { return x / (1.f + __expf(-x)); }
__device__ __forceinline__ float wave_sum(float v) {
#pragma unroll
    for (int o = 1; o < 64; o <<= 1) v += __shfl_xor(v, o);
    return v;
}

struct EpiStore16 {
    static constexpr bool PERM = true;
    bf16_t* O; int ldc;
    __device__ __forceinline__ void operator()(const f32x4 (&acc)[2][2][4][2], const pg8::Unit& u, int wr, int wc, int fr, int fq) const {
        const int row0 = (u.pm % MT) * 256 + wr * 64 + fr, col0 = u.pn * 256 + wc * 32 + 8 * fq;
#pragma unroll
        for (int ai = 0; ai < 2; ++ai)
#pragma unroll
            for (int m = 0; m < 4; ++m) { bf16_t* rowp = O + (size_t)(row0 + ai * 128 + m * 16) * ldc + col0;
#pragma unroll
                for (int bj = 0; bj < 2; ++bj) { const f32x4 v0 = acc[ai][bj][m][0], v1 = acc[ai][bj][m][1];
                    u32x4 w; w.x = pk2(v0[0], v0[1]); w.y = pk2(v0[2], v0[3]); w.z = pk2(v1[0], v1[1]); w.w = pk2(v1[2], v1[3]);
                    *(u32x4*)(rowp + bj * 128) = w; } }
    }
};
template <int MODE> struct EpiPair {
    static constexpr bool PERM = true;
    bf16_t* O; int ldc; const float* bias;
    __device__ __forceinline__ void operator()(const f32x4 (&acc)[2][2][4][2], const pg8::Unit& u, int wr, int wc, int fr, int fq) const {
        const int row0 = (u.pm % MT) * 256 + wr * 64 + fr, col0 = u.pn * 128 + wc * 32 + 8 * fq;
        float ba[8], bb[8];
#pragma unroll
        for (int j = 0; j < 8; ++j) { ba[j] = (MODE == 1) ? bias[col0 + j] : 0.f; bb[j] = (MODE == 1) ? bias[1024 + col0 + j] : 0.f; }
#pragma unroll
        for (int ai = 0; ai < 2; ++ai)
#pragma unroll
            for (int m = 0; m < 4; ++m) { bf16_t* rowp = O + (size_t)(row0 + ai * 128 + m * 16) * ldc + col0;
                float o[8];
#pragma unroll
                for (int n = 0; n < 2; ++n)
#pragma unroll
                    for (int j = 0; j < 4; ++j) { const float a = acc[ai][0][m][n][j] + ba[4 * n + j], b = acc[ai][1][m][n][j] + bb[4 * n + j];
                        o[4 * n + j] = (MODE == 0) ? siluf_(a) * b : a * sigmoidf_(b); }
                u32x4 w; w.x = pk2(o[0], o[1]); w.y = pk2(o[2], o[3]); w.z = pk2(o[4], o[5]); w.w = pk2(o[6], o[7]);
                *(u32x4*)rowp = w; }
    }
};
struct EpiF32 {
    static constexpr bool PERM = false;
    float* O; int ldc;
    __device__ __forceinline__ void operator()(const f32x4 (&acc)[2][2][4][2], const pg8::Unit& u, int wr, int wc, int fr, int fq) const {
        const int row0 = (u.pm % MT) * 256 + wr * 64 + fr, col0 = u.pn * 256 + wc * 32 + 4 * fq;
#pragma unroll
        for (int ai = 0; ai < 2; ++ai)
#pragma unroll
            for (int m = 0; m < 4; ++m) { float* rowp = O + (size_t)(row0 + ai * 128 + m * 16) * ldc + col0;
#pragma unroll
                for (int bj = 0; bj < 2; ++bj)
#pragma unroll
                    for (int n = 0; n < 2; ++n) *(f32x4*)(rowp + bj * 128 + n * 16) = acc[ai][bj][m][n]; }
    }
};
struct EpiG1 {
    static constexpr bool PERM = true;
    bf16_t* ys5; const float* glu_bias; bf16_t* br0; bf16_t* br1; const bf16_t* P;
    __device__ __forceinline__ void operator()(const f32x4 (&acc)[2][2][4][2], const pg8::Unit& u, int wr, int wc, int fr, int fq) const {
        const int gi = u.pn >> 3, pn = u.pn & 7;
        if (gi == 0) { pg8::Unit u2; u2.pm = u.pm; u2.pn = pn; EpiPair<1> e{ys5, 1024, glu_bias}; e(acc, u2, wr, wc, fr, fq); return; }
        bf16_t* br = (gi == 1) ? br0 : br1;
        const int row0 = (u.pm % MT) * 256 + wr * 64 + fr, col0 = pn * 256 + wc * 32 + 8 * fq;
#pragma unroll
        for (int ai = 0; ai < 2; ++ai)
#pragma unroll
            for (int m = 0; m < 4; ++m) { const int row = row0 + ai * 128 + m * 16;
#pragma unroll
                for (int bj = 0; bj < 2; ++bj) { const int col = col0 + bj * 128;
                    const u32x4 gw = *(const u32x4*)(P + (size_t)row * NINP + GATEOFF + (gi - 1) * 2048 + col); float gt[8]; unpack8(gw, gt);
                    const f32x4 v0 = acc[ai][bj][m][0], v1 = acc[ai][bj][m][1];
                    float o[8];
#pragma unroll
                    for (int j = 0; j < 4; ++j) { o[j] = sigmoidf_(gt[j]) * v0[j]; o[4 + j] = sigmoidf_(gt[4 + j]) * v1[j]; }
                    u32x4 w; w.x = pk2(o[0], o[1]); w.y = pk2(o[2], o[3]); w.z = pk2(o[4], o[5]); w.w = pk2(o[6], o[7]);
                    *(u32x4*)(br + (size_t)row * D + col) = w; } }
    }
};
struct EpiG2 {
    static constexpr bool PERM = true;
    bf16_t* mrg; const bf16_t* br0; const bf16_t* br1; const bf16_t* P;
    __device__ __forceinline__ void operator()(const f32x4 (&acc)[2][2][4][2], const pg8::Unit& u, int wr, int wc, int fr, int fq) const {
        const int row0 = (u.pm % MT) * 256 + wr * 64 + fr, col0 = u.pn * 256 + wc * 32 + 8 * fq;
#pragma unroll
        for (int ai = 0; ai < 2; ++ai)
#pragma unroll
            for (int m = 0; m < 4; ++m) { const int row = row0 + ai * 128 + m * 16;
#pragma unroll
                for (int bj = 0; bj < 2; ++bj) { const int col = col0 + bj * 128;
                    const u32x4 gw = *(const u32x4*)(P + (size_t)row * NINP + GATEOFF + 2 * 2048 + col); float gt[8]; unpack8(gw, gt);
                    const u32x4 w0 = *(const u32x4*)(br0 + (size_t)row * D + col); float b0[8]; unpack8(w0, b0);
                    const u32x4 w1 = *(const u32x4*)(br1 + (size_t)row * D + col); float b1[8]; unpack8(w1, b1);
                    const f32x4 v0 = acc[ai][bj][m][0], v1 = acc[ai][bj][m][1];
                    float o[8];
#pragma unroll
                    for (int j = 0; j < 4; ++j) { o[j] = b0[j] + b1[j] + sigmoidf_(gt[j]) * v0[j]; o[4 + j] = b0[4 + j] + b1[4 + j] + sigmoidf_(gt[4 + j]) * v1[j]; }
                    u32x4 w; w.x = pk2(o[0], o[1]); w.y = pk2(o[2], o[3]); w.z = pk2(o[4], o[5]); w.w = pk2(o[6], o[7]);
                    *(u32x4*)(mrg + (size_t)row * D + col) = w; } }
    }
};

__device__ __forceinline__ void mod_phase(const Args& a, float* lds, float* modv, int g0, int g1, int nblk) {
    const int tid = otid();
    const float* c = a.in[1]; const float* cc = a.in[3]; const float* W = a.in[4]; const float* bvec = a.in[5];
    bool staged = false;
    const int bxm = obid(); if (bxm >= nblk) return;
    for (int gidx = g0 + bxm; gidx < g1; gidx += nblk) {
        if (!staged) {
            for (int i = tid; i < 3 * 2048; i += NT) { const int v = i >> 11, k = i & 2047; const float x = (v < 2) ? c[v * 2048 + k] : cc[k]; lds[i] = siluf_(x); }
            staged = true;
        }
        __syncthreads();
        const int l = gidx >> 7, j0 = (gidx & 127) * 96;
        const int kg = tid / 24, cl = tid % 24;
        float acc[3][4];
#pragma unroll
        for (int v = 0; v < 3; ++v)
#pragma unroll
            for (int j = 0; j < 4; ++j) acc[v][j] = 0.f;
        if (kg < 21) {
            const float* wp = W + (size_t)l * 2048 * 12288 + j0 + 4 * cl;
#pragma unroll 14
            for (int k = kg; k < 2048; k += 21) {
                const f32x4 w = *(const f32x4*)(wp + (size_t)k * 12288);
                const float s0 = lds[k], s1 = lds[2048 + k], s2 = lds[4096 + k];
#pragma unroll
                for (int j = 0; j < 4; ++j) { acc[0][j] += s0 * w[j]; acc[1][j] += s1 * w[j]; acc[2][j] += s2 * w[j]; }
            }
            float* red = lds + 6144;
#pragma unroll
            for (int v = 0; v < 3; ++v)
#pragma unroll
                for (int j = 0; j < 4; ++j) red[(kg * 3 + v) * 96 + 4 * cl + j] = acc[v][j];
        }
        __syncthreads();
        if (tid < 288) { const int v = tid / 96, cidx = tid % 96; float s = bvec[l * 12288 + j0 + cidx];
            for (int g = 0; g < 21; ++g) s += lds[6144 + (g * 3 + v) * 96 + cidx];
            modv[(l * 3 + v) * 12288 + j0 + cidx] = s; }
        __syncthreads();
    }
}

__device__ __forceinline__ void transpose_item(const float* W, int K, int N, bf16_t* WT, int k0, int n0, int drow0, float* scr, int lane) {
    float tv[32];
#pragma unroll
    for (int i = 0; i < 32; ++i) { const int kk = 2 * i + (lane >> 5); tv[i] = W[(size_t)(k0 + kk) * N + n0 + (lane & 31)]; }
#pragma unroll
    for (int i = 0; i < 32; ++i) { const int kk = 2 * i + (lane >> 5); scr[kk * 33 + (lane & 31)] = tv[i]; }
    asm volatile("s_waitcnt vmcnt(0) lgkmcnt(0)" ::: "memory");
    const int c = lane & 7;
#pragma unroll
    for (int j = 0; j < 4; ++j) { const int n = (lane >> 3) + 8 * j; const float* s = scr + (8 * c) * 33 + n;
        u32x4 o; o.x = pk2(s[0 * 33], s[1 * 33]); o.y = pk2(s[2 * 33], s[3 * 33]); o.z = pk2(s[4 * 33], s[5 * 33]); o.w = pk2(s[6 * 33], s[7 * 33]);
        *(u32x4*)(WT + (size_t)(drow0 + n) * K + k0 + 8 * c) = o; }
    asm volatile("s_waitcnt lgkmcnt(0)" ::: "memory");
}
__device__ __forceinline__ int pair_row(int n0, int part) { return (n0 >> 7) * 256 + part * 128 + (n0 & 127); }
__device__ __forceinline__ void wconv_phase(const Args& a, int l, float* lds, int parts = 31, int blk0 = 0, int nblk = 1 << 30) {
    const int tid = otid(), lane = tid & 63, wave = tid >> 6;
    float* scr = lds + wave * 4096;
    const int bxw = obid();
    const int bend = ((int)gridDim.x < nblk) ? (int)gridDim.x : nblk;
    if (bxw < blk0 || bxw >= bend) return;
    const int gw = (bxw - blk0) * NWAVES + wave, NGW = (bend - blk0) * NWAVES;
    unsigned char* ws = a.ws;
    constexpr int I_IN = 32 * 401, I_GLU = 16 * 64, I_WB = 3 * 16 * 64, I_OUT = 32 * 64, I_G = 32 * 176, I_DN = 88 * 64;
    constexpr int TOTAL = I_IN + I_GLU + I_WB + I_OUT + 2 * I_G + I_DN;
    for (int it = gw; it < TOTAL; it += NGW) {
        int r = it;
        if (r < I_IN) { if (!(parts & (1 | 32 | 64))) { it += (I_IN - r - 1) / NGW * NGW; continue; }
            if (!((parts & 1) || ((parts & 32) && r < I_IN / 2) || ((parts & 64) && r >= I_IN / 2))) continue;
            const int kb = r / 401, nb = r % 401; transpose_item(a.in[10] + (size_t)l * 2048 * NIN, 2048, NIN, (bf16_t*)(ws + WS_WIN), 64 * kb, 32 * nb, 32 * nb, scr, lane); continue; } r -= I_IN;
        if (r < I_GLU) { if (!(parts & 2)) continue; const int kb = r / 64, nb = r % 64, n0 = 32 * nb; const int dr = (n0 < 1024) ? pair_row(n0, 0) : pair_row(n0 - 1024, 1);
            transpose_item(a.in[27] + (size_t)l * 1024 * 2048, 1024, 2048, (bf16_t*)(ws + WS_WSTK), 64 * kb, n0, dr, scr, lane); continue; } r -= I_GLU;
        if (r < I_WB) { if (!(parts & 2)) continue; const int bi = r / 1024, rr = r % 1024, kb = rr / 64, nb = rr % 64;
            transpose_item(a.in[29] + ((size_t)l * 3 + bi) * 1024 * 2048, 1024, 2048, (bf16_t*)(ws + WS_WSTK) + (size_t)(1 + bi) * 2048 * 1024, 64 * kb, 32 * nb, 32 * nb, scr, lane); continue; } r -= I_WB;
        if (r < I_OUT) { if (!(parts & 4)) continue; const int kb = r / 64, nb = r % 64; transpose_item(a.in[30] + (size_t)l * 2048 * 2048, 2048, 2048, (bf16_t*)(ws + WS_WOUT), 64 * kb, 32 * nb, 32 * nb, scr, lane); continue; } r -= I_OUT;
        if (r < I_G) { if (!(parts & 8)) continue; const int kb = r / 176, nb = r % 176; transpose_item(a.in[31] + (size_t)l * 2048 * DFF, 2048, DFF, (bf16_t*)(ws + WS_WGU), 64 * kb, 32 * nb, pair_row(32 * nb, 0), scr, lane); continue; } r -= I_G;
        if (r < I_G) { if (!(parts & 8)) continue; const int kb = r / 176, nb = r % 176; transpose_item(a.in[32] + (size_t)l * 2048 * DFF, 2048, DFF, (bf16_t*)(ws + WS_WGU), 64 * kb, 32 * nb, pair_row(32 * nb, 1), scr, lane); continue; } r -= I_G;
        if (parts & 16) { const int kb = r / 64, nb = r % 64; transpose_item(a.in[33] + (size_t)l * DFF * 2048, DFF, 2048, (bf16_t*)(ws + WS_WDN), 64 * kb, 32 * nb, 32 * nb, scr, lane); }
    }
}

struct RowPass {
    const float* src_lat; const float* src_ctx;
    float* dst_lat; float* dst_ctx;
    const bf16_t* o;
    const float* gpost; const float* gatev;
    bf16_t* h;
    const float* gpre; const float* shv; const float* scv;
    int nrows;
};
__device__ __forceinline__ void row_pass(const RowPass& rp) {
    const int tid = otid(), lane = tid & 63, wave = tid >> 6;
    const int gw = obid() * NWAVES + wave, NGW = gridDim.x * NWAVES;
    for (int row = gw; row < rp.nrows; row += NGW) {
        const int v = (row < MLAT) ? (row >> 12) : 2;
        const float* xs = (row < MLAT) ? rp.src_lat + (size_t)row * D : rp.src_ctx + (size_t)(row - MLAT) * D;
        f32x4 x[8];
#pragma unroll
        for (int j = 0; j < 8; ++j) x[j] = *(const f32x4*)(xs + 4 * (lane + 64 * j));
        if (rp.o) {
            const bf16_t* orow = rp.o + (size_t)row * D; f32x4 ov[8]; float ss = 0.f;
#pragma unroll
            for (int j = 0; j < 8; ++j) { const u32x2 w2 = *(const u32x2*)(orow + 4 * (lane + 64 * j));
                ov[j] = (f32x4){__uint_as_float(w2.x << 16), __uint_as_float(w2.x & 0xffff0000u), __uint_as_float(w2.y << 16), __uint_as_float(w2.y & 0xffff0000u)};
                ss += ov[j][0] * ov[j][0] + ov[j][1] * ov[j][1] + ov[j][2] * ov[j][2] + ov[j][3] * ov[j][3]; }
            const float rstd = rsqrtf(wave_sum(ss) * (1.f / D) + EPS);
#pragma unroll
            for (int j = 0; j < 8; ++j) { const int col = 4 * (lane + 64 * j); const f32x4 gp = *(const f32x4*)(rp.gpost + col); const f32x4 gt = *(const f32x4*)(rp.gatev + v * 12288 + col);
                x[j] = x[j] + gt * (ov[j] * rstd * gp); }
        }
        if (rp.dst_lat) { float* xd = (row < MLAT) ? rp.dst_lat + (size_t)row * D : rp.dst_ctx + (size_t)(row - MLAT) * D;
#pragma unroll
            for (int j = 0; j < 8; ++j) *(f32x4*)(xd + 4 * (lane + 64 * j)) = x[j]; }
        if (rp.h) {
            float ss = 0.f;
#pragma unroll
            for (int j = 0; j < 8; ++j) ss += x[j][0] * x[j][0] + x[j][1] * x[j][1] + x[j][2] * x[j][2] + x[j][3] * x[j][3];
            const float rstd = rsqrtf(wave_sum(ss) * (1.f / D) + EPS);
            bf16_t* hr = rp.h + (size_t)row * D;
#pragma unroll
            for (int j = 0; j < 8; ++j) { const int col = 4 * (lane + 64 * j); const f32x4 gp = *(const f32x4*)(rp.gpre + col); const f32x4 sh = *(const f32x4*)(rp.shv + v * 12288 + col); const f32x4 sc = *(const f32x4*)(rp.scv + v * 12288 + col);
                const f32x4 y = (x[j] * rstd * gp) * (sc + 1.f) + sh; u32x2 w; w.x = pk2(y[0], y[1]); w.y = pk2(y[2], y[3]); *(u32x2*)(hr + col) = w; }
        }
    }
}

__device__ __forceinline__ int row_of_pos(int b, int pos) { return (pos < CTXL) ? MLAT + b * CTXL + pos : b * SEQ + (pos - CTXL); }
template <bool SRC_BF16> __device__ __forceinline__ void tr_tile(const void* src, int stride, int col0, int myrow, float myscale, bf16_t* dst, float* wl, int lane) {
    float* scr = wl; int* rws = (int*)(wl + 64 * 65); float* scs = wl + 64 * 65 + 64;
    rws[lane] = myrow; scs[lane] = myscale;
    asm volatile("s_waitcnt lgkmcnt(0)" ::: "memory");
#pragma unroll 32
    for (int i = 0; i < 64; ++i) { const int r = rws[i]; float v;
        if (SRC_BF16) v = bf2f(((const bf16_t*)src)[(size_t)r * stride + col0 + lane]); else v = ((const float*)src)[(size_t)r * stride + col0 + lane] * scs[i];
        scr[i * 65 + lane] = v; }
    asm volatile("s_waitcnt vmcnt(0) lgkmcnt(0)" ::: "memory");
    const int pb = lane & 7, cl = lane >> 3, ib = 32 * (pb >> 2) + 16 * ((pb >> 1) & 1) + 4 * (pb & 1);
#pragma unroll
    for (int k = 0; k < 8; ++k) { const int j = cl + 8 * k; float v[8];
#pragma unroll
        for (int jj = 0; jj < 8; ++jj) v[jj] = scr[(ib + 8 * (jj >> 2) + (jj & 3)) * 65 + j];
        u32x4 w; w.x = pk2(v[0], v[1]); w.y = pk2(v[2], v[3]); w.z = pk2(v[4], v[5]); w.w = pk2(v[6], v[7]);
        *(u32x4*)(dst + (size_t)j * KVL + 8 * pb) = w; }
    asm volatile("s_waitcnt lgkmcnt(0)" ::: "memory");
}
__device__ __forceinline__ int seq_row(int b, int dir, int s);
__device__ __forceinline__ void prep_phase(const Args& a, int l, float* lds) {
    unsigned char* ws = a.ws;
    const bf16_t* P = (const bf16_t*)(ws + WS_P);
    bf16_t* Qr = (bf16_t*)(ws + WS_QR); bf16_t* Kr = (bf16_t*)(ws + WS_KR); bf16_t* Vt = (bf16_t*)(ws + WS_VT);
    float* xbc = (float*)(ws + WS_XBC); float* dtv = (float*)(ws + WS_DTV);
    const int gt = obid() * NT + otid(), GT = gridDim.x * NT;
    const float qscale = 0.125f * 1.4426950408889634f;
    for (int idx = gt; idx < MROWS * 128; idx += GT) {
        const int oct = idx & 7, hc = (idx >> 3) & 15, row = idx >> 7;
        const bool lat = row < MLAT; const int b = lat ? (row >> 12) : ((row - MLAT) >> 8); const int t = lat ? (row & 4095) : ((row - MLAT) & 255);
        const bf16_t* srcq = P + (size_t)row * NINP + QOFF + hc * 64; const bf16_t* srck = P + (size_t)row * NINP + KOFF + hc * 64;
        const u32x4 xqw = *(const u32x4*)(srcq + oct * 8), xkw = *(const u32x4*)(srck + oct * 8);
        const u32x4 pqw = *(const u32x4*)(srcq + (oct ^ 2) * 8), pkw = *(const u32x4*)(srck + (oct ^ 2) * 8);
        float xq[8], xk[8], oq[8], ok[8]; unpack8(xqw, xq); unpack8(xkw, xk);
        if (lat) {
            float pq[8], pk[8]; unpack8(pqw, pq); unpack8(pkw, pk);
            const float sign = (oct & 2) ? 1.f : -1.f; const float pos = (float)((oct & 4) ? (t & 63) : (t >> 6));
#pragma unroll
            for (int j = 0; j < 8; ++j) { const int f = (oct & 1) * 8 + j; const float inv = exp2f(-(float)f * 0.8304820237218406f); const float ang = pos * inv; float sn, cs; __sincosf(ang, &sn, &cs);
                oq[j] = (xq[j] * cs + sign * pq[j] * sn) * qscale; ok[j] = xk[j] * cs + sign * pk[j] * sn; }
        } else {
#pragma unroll
            for (int j = 0; j < 8; ++j) { oq[j] = xq[j] * qscale; ok[j] = xk[j]; }
        }
        const int pos4 = lat ? CTXL + t : t;
        const size_t dofs = ((size_t)(b * 16 + hc) * KVL + pos4) * 64 + oct * 8;
        u32x4 w; w.x = pk2(oq[0], oq[1]); w.y = pk2(oq[2], oq[3]); w.z = pk2(oq[4], oq[5]); w.w = pk2(oq[6], oq[7]);
        *(u32x4*)(Qr + dofs) = w;
        w.x = pk2(ok[0], ok[1]); w.y = pk2(ok[2], ok[3]); w.z = pk2(ok[4], ok[5]); w.w = pk2(ok[6], ok[7]);
        *(u32x4*)(Kr + dofs) = w;
    }
    { const int tid_ = otid(); const int lane = tid_ & 63, wave = tid_ >> 6; float* wl = lds + wave * 4288;
      const int gw = obid() * NWAVES + wave, NGW = gridDim.x * NWAVES;
      for (int tI = gw; tI < 16 * 2 * 68; tI += NGW) { const int pt = tI % 68, rest = tI / 68, dh = rest & 1, bh = rest >> 1, b = bh >> 3, h = bh & 7;
          tr_tile<true>(P, NINP, VOFF + h * 128 + 64 * dh, row_of_pos(b, 64 * pt + lane), 1.f, Vt + ((size_t)bh * 128 + 64 * dh) * KVL + 64 * pt, wl, lane); } }
    const float* cw = a.in[13] + (size_t)l * 5 * 1536; const float* cb = a.in[14] + (size_t)l * 1536;
    for (int idx = gt; idx < MROWS * 192; idx += GT) {
        const int k8 = idx % 192, row = idx / 192, ch0 = 8 * k8;
        const bool lat = row < MLAT; const int t = lat ? (row & 4095) : ((row - MLAT) & 255); const int n = lat ? SEQ : CTXL;
        float acc[8];
        { const f32x4 b0 = *(const f32x4*)(cb + ch0), b1 = *(const f32x4*)(cb + ch0 + 4);
#pragma unroll
          for (int j = 0; j < 4; ++j) { acc[j] = b0[j]; acc[4 + j] = b1[j]; } }
#pragma unroll
        for (int j = 0; j < 5; ++j) { const int tt = t + j - 2;
            if (tt >= 0 && tt < n) { const u32x4 xw = *(const u32x4*)(P + (size_t)(row + j - 2) * NINP + XBCOFF + ch0); float x[8]; unpack8(xw, x);
                const f32x4 w0 = *(const f32x4*)(cw + j * 1536 + ch0), w1 = *(const f32x4*)(cw + j * 1536 + ch0 + 4);
#pragma unroll
                for (int q = 0; q < 4; ++q) { acc[q] += w0[q] * x[q]; acc[4 + q] += w1[q] * x[4 + q]; } } }
        f32x4 o0, o1;
#pragma unroll
        for (int q = 0; q < 4; ++q) { o0[q] = siluf_(acc[q]); o1[q] = siluf_(acc[4 + q]); }
        *(f32x4*)(xbc + (size_t)row * 1536 + ch0) = o0; *(f32x4*)(xbc + (size_t)row * 1536 + ch0 + 4) = o1;
    }
    const float* dtb = a.in[15] + l * 32; const float* alog = a.in[16] + l * 32;
    for (int idx = gt; idx < MROWS * 32; idx += GT) {
        const int i = idx & 31, row = idx >> 5;
        const float v = bf2f(P[(size_t)row * NINP + DTOFF + i]) + dtb[i];
        const float dt = fmaxf(v, 0.f) + log1pf(__expf(-fabsf(v)));
        const float av = -__expf(alog[i]);
        dtv[row * 64 + i] = dt; dtv[row * 64 + 32 + i] = __expf(dt * av);
    }
}

#define MFMA32(a, b, c) __builtin_amdgcn_mfma_f32_32x32x16_bf16((a), (b), (c), 0, 0, 0)
__device__ __forceinline__ void attn_phase(const Args& a, int l, bool with_ctx, unsigned char* lds) {
    unsigned char* ws = a.ws;
    const bf16_t* Qr = (const bf16_t*)(ws + WS_QR); const bf16_t* Kr = (const bf16_t*)(ws + WS_KR); const bf16_t* Vt = (const bf16_t*)(ws + WS_VT);
    bf16_t* yat = (bf16_t*)(ws + WS_AST) + (size_t)1 * MROWS * 1024;
    const int tid = otid(), lane = tid & 63, wid = tid >> 6, r32 = lane & 31, hi = lane >> 5, c = wid & 1, qsub = wid >> 1;
    constexpr int KT = 2 * 64 * 144, VTB = 128 * 144, BUF = KT + VTB;
    float* xch = (float*)(lds + 2 * BUF);
    const float lam_init = 0.8f - 0.6f * __expf(-0.3f * (float)l);
    float lam;
    { const float* lf = a.in[11] + l * 256; float s1 = 0.f, s2 = 0.f;
      for (int i = 0; i < 64; ++i) { s1 += lf[i] * lf[64 + i]; s2 += lf[128 + i] * lf[192 + i]; }
      lam = __expf(s1) - __expf(s2) + lam_init; }
    const float* subln = a.in[12] + l * 128;
    const int G = gridDim.x, bx = obid();
    const int vcu = (G % 8 == 0) ? (bx % 8) * (G / 8) + bx / 8 : bx;
    const int skey = tid >> 3, spart = tid & 7;
    const int nunits = with_ctx ? 544 : 512;
    for (int u0 = 2 * vcu; u0 < nunits; u0 += 2 * G) {
      for (int it = 0; it < 2; ++it) {
        const int u = u0 + it;
        int bh, qbase, nkv;
        if (u < 512) { bh = u >> 5; qbase = CTXL + 128 * (u & 31); nkv = KVL; } else { bh = (u - 512) >> 1; qbase = 128 * ((u - 512) & 1); nkv = CTXL; }
        const int b = bh >> 3, h = bh & 7;
        const bf16_t* Kg0 = Kr + ((size_t)(bh * 2) * KVL + skey) * 64 + spart * 8;
        const bf16_t* Kg1 = Kg0 + (size_t)KVL * 64;
        const bf16_t* Vg0 = Vt + ((size_t)bh * 128 + skey) * KVL + spart * 8;
        const bf16_t* Vg1 = Vg0 + (size_t)64 * KVL;
        unsigned char* kdst = lds + skey * 144 + spart * 16;
        unsigned char* vdst = lds + KT + skey * 144 + spart * 16;
        const int qpos = qbase + qsub * 32 + r32;
        bf16x8 qf[4];
        { const bf16_t* Qb = Qr + ((size_t)(bh * 2 + c) * KVL + qpos) * 64 + 8 * hi;
#pragma unroll
          for (int d0 = 0; d0 < 4; ++d0) qf[d0] = *(const bf16x8*)(Qb + 16 * d0); }
        f32x16 O[4];
#pragma unroll
        for (int j = 0; j < 4; ++j)
#pragma unroll
            for (int r = 0; r < 16; ++r) O[j][r] = 0.f;
        float negm = 0.f, lrun = 0.f; bool first = true;
        u32x4 k0 = *(const u32x4*)Kg0, k1 = *(const u32x4*)Kg1, v0 = *(const u32x4*)Vg0, v1 = *(const u32x4*)Vg1;
        __syncthreads();
        *(u32x4*)kdst = k0; *(u32x4*)(kdst + 9216) = k1; *(u32x4*)vdst = v0; *(u32x4*)(vdst + 9216) = v1;
        __syncthreads();
        const int nt = nkv >> 6;
        for (int t = 0; t < nt; ++t) {
            const int cur = t & 1;
            if (t + 1 < nt) { k0 = *(const u32x4*)(Kg0 + (size_t)(t + 1) * 64 * 64); k1 = *(const u32x4*)(Kg1 + (size_t)(t + 1) * 64 * 64);
                              v0 = *(const u32x4*)(Vg0 + (t + 1) * 64); v1 = *(const u32x4*)(Vg1 + (t + 1) * 64); }
#pragma unroll
            for (int sub = 0; sub < 2; ++sub) {
                const unsigned char* kb = lds + cur * BUF + c * 9216 + (32 * sub + r32) * 144 + hi * 16;
                const unsigned char* vb = lds + cur * BUF + KT + r32 * 144 + 64 * sub + hi * 16;
                bf16x8 kf[4], vf[8];
#pragma unroll
                for (int d0 = 0; d0 < 4; ++d0) kf[d0] = *(const bf16x8*)(kb + d0 * 32);
#pragma unroll
                for (int j = 0; j < 4; ++j) { vf[2 * j] = *(const bf16x8*)(vb + j * 32 * 144); vf[2 * j + 1] = *(const bf16x8*)(vb + j * 32 * 144 + 32); }
                __builtin_amdgcn_sched_barrier(0);
                f32x16 S;
#pragma unroll
                for (int r = 0; r < 16; ++r) S[r] = negm;
#pragma unroll
                for (int d0 = 0; d0 < 4; ++d0) S = MFMA32(kf[d0], qf[d0], S);
                float mx = S[0];
#pragma unroll
                for (int r = 1; r < 16; ++r) mx = fmaxf(mx, S[r]);
                if (first || __any(mx > 8.f)) {
                    mx = fmaxf(mx, __shfl_xor(mx, 32));
                    const float dl = first ? mx : fmaxf(mx, 0.f); const float alpha = first ? 1.f : __builtin_amdgcn_exp2f(-dl); negm -= dl; lrun *= alpha; first = false;
#pragma unroll
                    for (int r = 0; r < 16; ++r) S[r] -= dl;
#pragma unroll
                    for (int j = 0; j < 4; ++j)
#pragma unroll
                        for (int r = 0; r < 16; ++r) O[j][r] *= alpha;
                }
                float ps = 0.f;
#pragma unroll
                for (int r = 0; r < 16; ++r) { S[r] = __builtin_amdgcn_exp2f(S[r]); ps += S[r]; }
                lrun += ps;
                u32x4 p0, p1;
                p0.x = pk2(S[0], S[1]); p0.y = pk2(S[2], S[3]); p0.z = pk2(S[4], S[5]); p0.w = pk2(S[6], S[7]);
                p1.x = pk2(S[8], S[9]); p1.y = pk2(S[10], S[11]); p1.z = pk2(S[12], S[13]); p1.w = pk2(S[14], S[15]);
                const bf16x8 pa0 = __builtin_bit_cast(bf16x8, p0), pa1 = __builtin_bit_cast(bf16x8, p1);
#pragma unroll
                for (int j = 0; j < 4; ++j) O[j] = MFMA32(vf[2 * j], pa0, O[j]);
#pragma unroll
                for (int j = 0; j < 4; ++j) O[j] = MFMA32(vf[2 * j + 1], pa1, O[j]);
            }
            if (t + 1 < nt) { unsigned char* kd = kdst + (cur ^ 1) * BUF; unsigned char* vd = vdst + (cur ^ 1) * BUF;
                *(u32x4*)kd = k0; *(u32x4*)(kd + 9216) = k1; *(u32x4*)vd = v0; *(u32x4*)(vd + 9216) = v1; }
            __syncthreads();
        }
        const float ltot = lrun + __shfl_xor(lrun, 32); const float inv = 1.f / ltot;
        float* xp = xch + qsub * 4096 + lane;
        if (c == 1) { const float li = lam * inv;
#pragma unroll
            for (int j = 0; j < 4; ++j)
#pragma unroll
                for (int r = 0; r < 16; ++r) xp[(j * 16 + r) * 64] = li * O[j][r]; }
        __syncthreads();
        if (c == 0) {
            float ss = 0.f;
#pragma unroll
            for (int j = 0; j < 4; ++j)
#pragma unroll
                for (int r = 0; r < 16; ++r) { const float v = O[j][r] * inv - xp[(j * 16 + r) * 64]; O[j][r] = v; ss += v * v; }
            ss += __shfl_xor(ss, 32);
            const float sc = rsqrtf(ss * (1.f / 128.f) + EPS) * (1.f - lam_init);
            const int row = row_of_pos(b, qpos);
            bf16_t* orow = yat + (size_t)row * 1024 + h * 128;
#pragma unroll
            for (int j = 0; j < 4; ++j)
#pragma unroll
                for (int rq = 0; rq < 4; ++rq) { const int dv = 32 * j + 8 * rq + 4 * hi; const f32x4 g = *(const f32x4*)(subln + dv);
                    u32x2 w; w.x = pk2(O[j][4 * rq] * sc * g[0], O[j][4 * rq + 1] * sc * g[1]); w.y = pk2(O[j][4 * rq + 2] * sc * g[2], O[j][4 * rq + 3] * sc * g[3]);
                    *(u32x2*)(orow + dv) = w; }
        }
      }
    }
}

__device__ __forceinline__ int seq_row(int b, int dir, int s) {
    if (s < CTXL) return MLAT + b * CTXL + (dir ? (CTXL - 1 - s) : s);
    const int t = s - CTXL; return b * SEQ + (dir ? (SEQ - 1 - t) : t);
}
__device__ __forceinline__ void la_phase(const Args& a, int l) {
    unsigned char* ws = a.ws;
    const bf16_t* P = (const bf16_t*)(ws + WS_P); float* LA = (float*)(ws + WS_LA);
    const float* dtb = a.in[15] + l * 32; const float* alog = a.in[16] + l * 32;
    const int tid = otid(), lane = tid & 63, wave = tid >> 6;
    const int gw = obid() * NWAVES + wave, NGW = gridDim.x * NWAVES;
    for (int u = gw; u < 64 * NCH; u += NGW) {
        const int combo = u % 64, ch = u / 64, head = combo & 15, dir = (combo >> 4) & 1, b = combo >> 5;
        const int i = dir * 16 + head; const float av = -__expf(alog[i]), bias = dtb[i];
        float v[4]; float run = 0.f;
#pragma unroll
        for (int k = 0; k < 4; ++k) { const int sp = ch * 256 + lane * 4 + k; const int row = seq_row(b, dir, sp);
            const float x = bf2f(P[(size_t)row * NINP + DTOFF + i]) + bias; const float dt = fmaxf(x, 0.f) + log1pf(__expf(-fabsf(x)));
            run += dt * av; v[k] = run; }
        float incl = run;
#pragma unroll
        for (int o = 1; o < 64; o <<= 1) { const float t = __shfl_up(incl, o); if (lane >= o) incl += t; }
        const float excl = incl - run;
        *(f32x4*)(LA + (size_t)combo * KVL + ch * 256 + lane * 4) = (f32x4){v[0] + excl, v[1] + excl, v[2] + excl, v[3] + excl};
    }
}
__device__ __forceinline__ void prep2_phase(const Args& a, float* lds) {
    unsigned char* ws = a.ws;
    const float* xbc = (const float*)(ws + WS_XBC); const float* dtv = (const float*)(ws + WS_DTV);
    bf16_t* XDT = (bf16_t*)(ws + WS_XDT); bf16_t* BT = (bf16_t*)(ws + WS_BT); bf16_t* BN = (bf16_t*)(ws + WS_BN); bf16_t* CN = (bf16_t*)(ws + WS_CN);
    const int gt = obid() * NT + otid(), GT = gridDim.x * NT;
    { const int tid_ = otid(); const int lane = tid_ & 63, wave = tid_ >> 6; float* wl = lds + wave * 4288;
      const int gw = obid() * NWAVES + wave, NGW = gridDim.x * NWAVES;
      for (int tI = gw; tI < 4 * 16 * 68 + 8 * 2 * 68; tI += NGW) {
          if (tI < 4 * 16 * 68) { const int pt = tI % 68, rest = tI / 68, head = rest & 15, bd = rest >> 4, b = bd >> 1, dir = bd & 1;
              const int row = seq_row(b, dir, 64 * pt + lane);
              tr_tile<false>(xbc, 1536, head * 64, row, dtv[row * 64 + dir * 16 + head], XDT + ((size_t)bd * 1024 + head * 64) * KVL + 64 * pt, wl, lane);
          } else { const int t2 = tI - 4 * 16 * 68; const int pt = t2 % 68, rest = t2 / 68, nh = rest & 1, bdg = rest >> 1, g = bdg & 1, dir = (bdg >> 1) & 1, b = bdg >> 2;
              tr_tile<false>(xbc, 1536, 1024 + g * 128 + 64 * nh, seq_row(b, dir, 64 * pt + lane), 1.f, BT + ((size_t)bdg * 128 + 64 * nh) * KVL + 64 * pt, wl, lane); }
      } }
    for (int idx = gt; idx < 8 * KVL * 16; idx += GT) {
        const int oct = idx & 15, rest = idx >> 4, sp = rest % KVL, bdg = rest / KVL, g = bdg & 1, dir = (bdg >> 1) & 1, b = bdg >> 2;
        const int row = seq_row(b, dir, sp);
        const float* src = xbc + (size_t)row * 1536 + 1024 + g * 128 + oct * 8;
        const f32x4 b0 = *(const f32x4*)src, b1 = *(const f32x4*)(src + 4), c0 = *(const f32x4*)(src + 256), c1 = *(const f32x4*)(src + 260);
        u32x4 w; w.x = pk2(b0[0], b0[1]); w.y = pk2(b0[2], b0[3]); w.z = pk2(b1[0], b1[1]); w.w = pk2(b1[2], b1[3]);
        *(u32x4*)(BN + ((size_t)bdg * KVL + sp) * 128 + oct * 8) = w;
        w.x = pk2(c0[0], c0[1]); w.y = pk2(c0[2], c0[3]); w.z = pk2(c1[0], c1[1]); w.w = pk2(c1[2], c1[3]);
        *(u32x4*)(CN + ((size_t)bdg * KVL + sp) * 128 + oct * 8) = w;
    }
}
__device__ __forceinline__ void ssd_state_phase(const Args& a, float* lds) {
    unsigned char* ws = a.ws;
    const bf16_t* XDT = (const bf16_t*)(ws + WS_XDT); const bf16_t* BT = (const bf16_t*)(ws + WS_BT); const float* LA = (const float*)(ws + WS_LA);
    bf16_t* HINB = (bf16_t*)(ws + WS_HINB);
    const int tid = otid(), lane = tid & 63, wid = tid >> 6, r32 = lane & 31, hi = lane >> 5, pb = wid & 1, nb = wid >> 1;
    const int sblk0 = ((int)gridDim.x >= 128) ? (int)gridDim.x - 64 : 0;
    for (int combo = obid() - sblk0; combo < 64; combo += (int)gridDim.x - sblk0) {
        if (combo < 0) break;
        const int head = combo & 15, bd = combo >> 4, g = head >> 3;
        const bf16_t* xa = XDT + ((size_t)bd * 1024 + head * 64 + 32 * pb + r32) * KVL + 8 * hi;
        const bf16_t* bb = BT + ((size_t)(bd * 2 + g) * 128 + 32 * nb + r32) * KVL + 8 * hi;
        f32x16 Hs;
#pragma unroll
        for (int r = 0; r < 16; ++r) Hs[r] = 0.f;
        for (int c = 0; c < NCH; ++c) {
            bf16_t* hout = HINB + ((size_t)(combo * NCH + c)) * 8192 + 32 * nb + r32;
#pragma unroll
            for (int r = 0; r < 16; ++r) { const int p = 32 * pb + (r & 3) + 8 * (r >> 2) + 4 * hi; hout[p * 128] = (bf16_t)(pk2(Hs[r], 0.f) & 0xffffu); }
            if (c == NCH - 1) break;
            const float* lac = LA + (size_t)combo * KVL + c * 256;
            const float lalast = lac[255];
            __syncthreads();
            if (tid < 256) { const int tok = (tid & ~12) | ((tid & 4) << 1) | ((tid & 8) >> 1); lds[tid] = __expf(lalast - lac[tok]); }
            __syncthreads();
            f32x16 S;
#pragma unroll
            for (int r = 0; r < 16; ++r) S[r] = 0.f;
#pragma unroll
            for (int k = 0; k < 16; ++k) {
                const u32x4 xw = *(const u32x4*)(xa + c * 256 + 16 * k); const bf16x8 bf = *(const bf16x8*)(bb + c * 256 + 16 * k);
                float xv[8]; unpack8(xw, xv);
                const f32x4 w0 = *(const f32x4*)(lds + 16 * k + 8 * hi), w1 = *(const f32x4*)(lds + 16 * k + 8 * hi + 4);
                u32x4 sw; sw.x = pk2(xv[0] * w0[0], xv[1] * w0[1]); sw.y = pk2(xv[2] * w0[2], xv[3] * w0[3]); sw.z = pk2(xv[4] * w1[0], xv[5] * w1[1]); sw.w = pk2(xv[6] * w1[2], xv[7] * w1[3]);
                S = MFMA32(__builtin_bit_cast(bf16x8, sw), bf, S);
            }
            const float dec = __expf(lalast);
#pragma unroll
            for (int r = 0; r < 16; ++r) Hs[r] = Hs[r] * dec + S[r];
        }
    }
}
__device__ __forceinline__ void ssd_out_phase(const Args& a, unsigned char* lds, int ch_lo) {
    unsigned char* ws = a.ws;
    const bf16_t* XDT = (const bf16_t*)(ws + WS_XDT); const bf16_t* BN = (const bf16_t*)(ws + WS_BN); const bf16_t* CN = (const bf16_t*)(ws + WS_CN);
    const bf16_t* HINB = (const bf16_t*)(ws + WS_HINB); const float* LA = (const float*)(ws + WS_LA); bf16_t* yssd = (bf16_t*)(ws + WS_YSSD);
    const int tid = otid(), lane = tid & 63, w = tid >> 6, r32 = lane & 31, hi = lane >> 5;
    constexpr int BNS = 0, XTS = 256 * 272, HNS = XTS + 64 * 528, LAS_ = HNS + 64 * 272;
    const float* la_s = (const float*)(lds + LAS_);
    const int nunits = 64 * (NCH - ch_lo);
    for (int u = obid(); u < nunits; u += gridDim.x) {
        const int combo = u % 64, c = ch_lo + u / 64;
        const int head = combo & 15, bd = combo >> 4, dir = bd & 1, b = bd >> 1, g = head >> 3;
        u32x4 sb[8], sx[4], sh[2];
        { const bf16_t* src = BN + ((size_t)(bd * 2 + g) * KVL + c * 256) * 128;
#pragma unroll
          for (int it = 0; it < 8; ++it) { const int q = tid + NT * it; sb[it] = *(const u32x4*)(src + (size_t)(q >> 4) * 128 + (q & 15) * 8); } }
        { const bf16_t* src = XDT + ((size_t)bd * 1024 + head * 64) * KVL + c * 256;
#pragma unroll
          for (int it = 0; it < 4; ++it) { const int q = tid + NT * it; sx[it] = *(const u32x4*)(src + (size_t)(q >> 5) * KVL + (q & 31) * 8); } }
        { const bf16_t* src = HINB + ((size_t)(combo * NCH + c)) * 8192;
#pragma unroll
          for (int it = 0; it < 2; ++it) { const int q = tid + NT * it; sh[it] = *(const u32x4*)(src + (size_t)q * 8); } }
        const float lav = (tid < 256) ? LA[(size_t)combo * KVL + c * 256 + tid] : 0.f;
        const int qi = 32 * w + r32;
        bf16x8 qf[8];
        { const bf16_t* cq = CN + ((size_t)(bd * 2 + g) * KVL + c * 256 + qi) * 128 + 8 * hi;
#pragma unroll
          for (int kn = 0; kn < 8; ++kn) qf[kn] = *(const bf16x8*)(cq + 16 * kn); }
        __syncthreads();
#pragma unroll
        for (int it = 0; it < 8; ++it) { const int q = tid + NT * it; *(u32x4*)(lds + BNS + (q >> 4) * 272 + (q & 15) * 16) = sb[it]; }
#pragma unroll
        for (int it = 0; it < 4; ++it) { const int q = tid + NT * it; *(u32x4*)(lds + XTS + (q >> 5) * 528 + (q & 31) * 16) = sx[it]; }
#pragma unroll
        for (int it = 0; it < 2; ++it) { const int q = tid + NT * it; *(u32x4*)(lds + HNS + (q >> 4) * 272 + (q & 15) * 16) = sh[it]; }
        if (tid < 256) ((float*)(lds + LAS_))[tid] = lav;
        __syncthreads();
        const float lai = la_s[qi];
        f32x16 Oo[2], O[2];
#pragma unroll
        for (int pb = 0; pb < 2; ++pb)
#pragma unroll
            for (int r = 0; r < 16; ++r) { Oo[pb][r] = 0.f; O[pb][r] = 0.f; }
#pragma unroll
        for (int pb = 0; pb < 2; ++pb)
#pragma unroll
            for (int kn = 0; kn < 8; ++kn) { const bf16x8 hf = *(const bf16x8*)(lds + HNS + (32 * pb + r32) * 272 + 32 * kn + 16 * hi); Oo[pb] = MFMA32(hf, qf[kn], Oo[pb]); }
        for (int jb = 0; jb <= w; ++jb) {
            bf16x8 kf[8], vf[4];
#pragma unroll
            for (int kn = 0; kn < 8; ++kn) kf[kn] = *(const bf16x8*)(lds + BNS + (32 * jb + r32) * 272 + 32 * kn + 16 * hi);
#pragma unroll
            for (int pb = 0; pb < 2; ++pb) { vf[2 * pb] = *(const bf16x8*)(lds + XTS + (32 * pb + r32) * 528 + 64 * jb + 16 * hi); vf[2 * pb + 1] = *(const bf16x8*)(lds + XTS + (32 * pb + r32) * 528 + 64 * jb + 32 + 16 * hi); }
            f32x16 S;
#pragma unroll
            for (int r = 0; r < 16; ++r) S[r] = 0.f;
#pragma unroll
            for (int kn = 0; kn < 8; ++kn) S = MFMA32(kf[kn], qf[kn], S);
#pragma unroll
            for (int q = 0; q < 4; ++q) { const f32x4 lj = *(const f32x4*)(la_s + 32 * jb + 8 * q + 4 * hi);
#pragma unroll
                for (int e = 0; e < 4; ++e) { const int j = 32 * jb + 8 * q + 4 * hi + e; const float wgt = (j <= qi) ? __expf(fminf(lai - lj[e], 0.f)) : 0.f; S[4 * q + e] *= wgt; } }
            u32x4 p0, p1;
            p0.x = pk2(S[0], S[1]); p0.y = pk2(S[2], S[3]); p0.z = pk2(S[4], S[5]); p0.w = pk2(S[6], S[7]);
            p1.x = pk2(S[8], S[9]); p1.y = pk2(S[10], S[11]); p1.z = pk2(S[12], S[13]); p1.w = pk2(S[14], S[15]);
            const bf16x8 pa0 = __builtin_bit_cast(bf16x8, p0), pa1 = __builtin_bit_cast(bf16x8, p1);
#pragma unroll
            for (int pb = 0; pb < 2; ++pb) { O[pb] = MFMA32(vf[2 * pb], pa0, O[pb]); O[pb] = MFMA32(vf[2 * pb + 1], pa1, O[pb]); }
        }
        const float ei = __expf(lai);
        const int row = seq_row(b, dir, c * 256 + qi);
        bf16_t* yo = yssd + ((size_t)dir * MROWS + row) * 1024 + head * 64;
#pragma unroll
        for (int pb = 0; pb < 2; ++pb)
#pragma unroll
            for (int q = 0; q < 4; ++q) { f32x4 o;
#pragma unroll
                for (int e = 0; e < 4; ++e) o[e] = O[pb][4 * q + e] + ei * Oo[pb][4 * q + e];
                u32x2 w2; w2.x = pk2(o[0], o[1]); w2.y = pk2(o[2], o[3]); *(u32x2*)(yo + 32 * pb + 8 * q + 4 * hi) = w2; }
    }
}

__device__ __forceinline__ void s5_phase(const Args& a, int l, unsigned char* ldsb) {
    unsigned char* ws = a.ws;
    const bf16_t* P = (const bf16_t*)(ws + WS_P); bf16_t* ys5 = (bf16_t*)(ws + WS_YS5);
    const int tid = otid(), lane = tid & 63, w = tid >> 6, r32 = lane & 31, hi = lane >> 5;
    f32x2v* Eseg = (f32x2v*)ldsb;
    unsigned char* hb = ldsb + 16384 + w * 8704;
    const int hh = (r32 >> 2) & 1, rr = (r32 & 3) + 4 * (r32 >> 3), tl = 16 * hh + rr;
    const int mysg = 2 * w + hi;
    for (int u = obid(); u < 256; u += gridDim.x) {
        const int g = u & 63, dir = (u >> 6) & 1, b = u >> 7;
        float lbr[2], lbi[2], l16r[2], l16i[2]; bf16x8 bre[2], bim[2];
#pragma unroll
        for (int pbk = 0; pbk < 2; ++pbk) {
            const int p = 32 * pbk + r32;
            const size_t li = ((size_t)(l * 2 + dir) * 64 + g) * 64 + p;
            const float lre = a.in[19][li], lim = a.in[20][li];
            const float delta = __expf(a.in[21][(l * 2 + dir) * 64 + g]);
            const float er = __expf(lre * delta); float sn, cs; __sincosf(lim * delta, &sn, &cs);
            const float xr = er * cs, xi = er * sn; lbr[pbk] = xr; lbi[pbk] = xi;
            const float den = 1.f / (lre * lre + lim * lim);
            const float cr = ((xr - 1.f) * lre + xi * lim) * den, ci = (xi * lre - (xr - 1.f) * lim) * den;
            const float* bre_g = a.in[22] + (((size_t)l * 64 + g) * 64 + p) * 16 + 8 * hi; const float* bim_g = a.in[23] + (((size_t)l * 64 + g) * 64 + p) * 16 + 8 * hi;
            float fr[8], fi[8];
#pragma unroll
            for (int j = 0; j < 8; ++j) { const float x = bre_g[j], y = bim_g[j]; fr[j] = cr * x - ci * y; fi[j] = cr * y + ci * x; }
            u32x4 t; t.x = pk2(fr[0], fr[1]); t.y = pk2(fr[2], fr[3]); t.z = pk2(fr[4], fr[5]); t.w = pk2(fr[6], fr[7]); bre[pbk] = __builtin_bit_cast(bf16x8, t);
            t.x = pk2(fi[0], fi[1]); t.y = pk2(fi[2], fi[3]); t.z = pk2(fi[4], fi[5]); t.w = pk2(fi[6], fi[7]); bim[pbk] = __builtin_bit_cast(bf16x8, t);
            float pr_ = xr, pi_ = xi;
#pragma unroll
            for (int k = 0; k < 4; ++k) { const float nr = pr_ * pr_ - pi_ * pi_, ni = 2.f * pr_ * pi_; pr_ = nr; pi_ = ni; }
            l16r[pbk] = pr_; l16i[pbk] = pi_;
        }
        bf16x8 cA[8];
#pragma unroll
        for (int kk = 0; kk < 8; ++kk) {
            u32x4 t = (u32x4){0u, 0u, 0u, 0u};
            if (r32 < 16) { const size_t ci_ = (((size_t)l * 64 + g) * 16 + r32) * 64 + 8 * kk + 4 * hi;
                const f32x4 c4 = *(const f32x4*)(a.in[24] + ci_), d4 = *(const f32x4*)(a.in[25] + ci_);
                t.x = pk2(c4[0], -d4[0]); t.y = pk2(c4[1], -d4[1]); t.z = pk2(c4[2], -d4[2]); t.w = pk2(c4[3], -d4[3]); }
            cA[kk] = __builtin_bit_cast(bf16x8, t);
        }
        float Hcr[2] = {0.f, 0.f}, Hci[2] = {0.f, 0.f};
        u32x4 unext = *(const u32x4*)(P + (size_t)seq_row(b, dir, 32 * w + tl) * NINP + UOFF + g * 16 + 8 * hi);
        for (int tile = 0; tile < NCH; ++tile) {
            const u32x4 ucur = unext;
            if (tile + 1 < NCH) unext = *(const u32x4*)(P + (size_t)seq_row(b, dir, (tile + 1) * 256 + 32 * w + tl) * NINP + UOFF + g * 16 + 8 * hi);
            const bf16x8 uA = __builtin_bit_cast(bf16x8, ucur);
            f32x16 Dre[2], Dim[2]; f32x16 zero;
#pragma unroll
            for (int r = 0; r < 16; ++r) zero[r] = 0.f;
            f32x2v* Ew = Eseg + (tile & 1) * 1024;
#pragma unroll
            for (int pbk = 0; pbk < 2; ++pbk) {
                Dre[pbk] = MFMA32(uA, bre[pbk], zero); Dim[pbk] = MFMA32(uA, bim[pbk], zero);
                float hr = 0.f, hi_ = 0.f;
#pragma unroll
                for (int r = 0; r < 16; ++r) { const float nr = lbr[pbk] * hr - lbi[pbk] * hi_ + Dre[pbk][r], ni = lbr[pbk] * hi_ + lbi[pbk] * hr + Dim[pbk][r];
                    hr = nr; hi_ = ni; Dre[pbk][r] = hr; Dim[pbk][r] = hi_; }
                Ew[mysg * 64 + 32 * pbk + r32] = (f32x2v){hr, hi_};
            }
            __syncthreads();
#pragma unroll
            for (int pbk = 0; pbk < 2; ++pbk) {
                float cr_ = Hcr[pbk], ci2 = Hci[pbk], inr = 0.f, ini = 0.f;
#pragma unroll
                for (int sg = 0; sg < 16; ++sg) {
                    if (sg == mysg) { inr = cr_; ini = ci2; }
                    const f32x2v e = Ew[sg * 64 + 32 * pbk + r32];
                    const float nr = l16r[pbk] * cr_ - l16i[pbk] * ci2 + e.x, ni = l16r[pbk] * ci2 + l16i[pbk] * cr_ + e.y;
                    cr_ = nr; ci2 = ni;
                }
                Hcr[pbk] = cr_; Hci[pbk] = ci2;
#pragma unroll
                for (int r = 0; r < 16; ++r) { const float nr = lbr[pbk] * inr - lbi[pbk] * ini, ni = lbr[pbk] * ini + lbi[pbk] * inr; inr = nr; ini = ni;
                    *(unsigned*)(hb + (16 * hi + r) * 272 + 4 * (32 * pbk + r32)) = pk2(Dre[pbk][r] + inr, Dim[pbk][r] + ini); }
            }
            asm volatile("s_waitcnt lgkmcnt(0)" ::: "memory");
            f32x16 Y = zero;
#pragma unroll
            for (int kk = 0; kk < 8; ++kk) { const bf16x8 hB = *(const bf16x8*)(hb + r32 * 272 + 32 * kk + 16 * hi); Y = MFMA32(cA[kk], hB, Y); }
            const int row = seq_row(b, dir, tile * 256 + 32 * w + r32);
            bf16_t* yo = ys5 + ((size_t)dir * MROWS + row) * 1024 + g * 16 + 4 * hi;
            { u32x2 w2; w2.x = pk2(Y[0], Y[1]); w2.y = pk2(Y[2], Y[3]); *(u32x2*)yo = w2; w2.x = pk2(Y[4], Y[5]); w2.y = pk2(Y[6], Y[7]); *(u32x2*)(yo + 8) = w2; }
            asm volatile("s_waitcnt lgkmcnt(0)" ::: "memory");
        }
        __syncthreads();
    }
}

__device__ __forceinline__ float gelu_tanh(float x) { const float t = 0.7978845608028654f * (x + 0.044715f * x * x * x); const float e = __expf(2.f * t); const float th = 1.f - 2.f / (e + 1.f); return 0.5f * x * (1.f + th); }
__device__ __forceinline__ void post_phase(const Args& a, int l, int nrows) {
    unsigned char* ws = a.ws;
    const bf16_t* P = (const bf16_t*)(ws + WS_P); const float* xbc = (const float*)(ws + WS_XBC);
    const bf16_t* yssd = (const bf16_t*)(ws + WS_YSSD); const bf16_t* ys5 = (const bf16_t*)(ws + WS_YS5);
    bf16_t* s5g = (bf16_t*)(ws + WS_AST); bf16_t* yss = (bf16_t*)(ws + WS_AST) + (size_t)2 * MROWS * 1024;
    const float* dssd = a.in[17] + l * 16; const float* gn = a.in[18] + l * 1024; const float* ds5 = a.in[26] + l * 1024;
    const int tid = otid(), lane = tid & 63, wave = tid >> 6;
    const int gw = obid() * NWAVES + wave, NGW = gridDim.x * NWAVES;
    for (int row = gw; row < nrows; row += NGW) {
        float v[2][8]; float ss = 0.f;
#pragma unroll
        for (int k = 0; k < 2; ++k) { const int ch = 8 * lane + 512 * k; const float dd = dssd[ch >> 6];
            const u32x4 zw = *(const u32x4*)(P + (size_t)row * NINP + ZOFF + ch); float z[8]; unpack8(zw, z);
            float yf[8], yb[8]; unpack8(*(const u32x4*)(yssd + (size_t)row * 1024 + ch), yf); unpack8(*(const u32x4*)(yssd + ((size_t)MROWS + row) * 1024 + ch), yb);
#pragma unroll
            for (int q = 0; q < 2; ++q) { const f32x4 xv = *(const f32x4*)(xbc + (size_t)row * 1536 + ch + 4 * q);
#pragma unroll
                for (int j = 0; j < 4; ++j) { const float y = (yf[4 * q + j] + yb[4 * q + j] + dd * xv[j]) * siluf_(z[4 * q + j]); v[k][4 * q + j] = y; ss += y * y; } } }
        const float rstd = rsqrtf(wave_sum(ss) * (1.f / 1024.f) + EPS);
#pragma unroll
        for (int k = 0; k < 2; ++k) { const int ch = 8 * lane + 512 * k; const f32x4 g0 = *(const f32x4*)(gn + ch), g1 = *(const f32x4*)(gn + ch + 4);
            u32x4 w; w.x = pk2(v[k][0] * rstd * g0[0], v[k][1] * rstd * g0[1]); w.y = pk2(v[k][2] * rstd * g0[2], v[k][3] * rstd * g0[3]);
            w.z = pk2(v[k][4] * rstd * g1[0], v[k][5] * rstd * g1[1]); w.w = pk2(v[k][6] * rstd * g1[2], v[k][7] * rstd * g1[3]);
            *(u32x4*)(yss + (size_t)row * 1024 + ch) = w; }
#pragma unroll
        for (int k = 0; k < 2; ++k) { const int ch = 8 * lane + 512 * k;
            const u32x4 uw = *(const u32x4*)(P + (size_t)row * NINP + UOFF + ch); float uu[8]; unpack8(uw, uu); float o[8];
            float yf[8], yb[8]; unpack8(*(const u32x4*)(ys5 + (size_t)row * 1024 + ch), yf); unpack8(*(const u32x4*)(ys5 + ((size_t)MROWS + row) * 1024 + ch), yb);
#pragma unroll
            for (int q = 0; q < 2; ++q) { const f32x4 dv = *(const f32x4*)(ds5 + ch + 4 * q);
#pragma unroll
                for (int j = 0; j < 4; ++j) o[4 * q + j] = gelu_tanh(yf[4 * q + j] + yb[4 * q + j] + dv[j] * uu[4 * q + j]); }
            u32x4 w; w.x = pk2(o[0], o[1]); w.y = pk2(o[2], o[3]); w.z = pk2(o[4], o[5]); w.w = pk2(o[6], o[7]);
            *(u32x4*)(s5g + (size_t)row * 1024 + ch) = w; }
    }
}

#define LAS __attribute__((address_space(3)))
#define XB_TMO      128
#define XB_XCNT(j)  (256  + 64 * (j))
#define XB_XSUB(j)  (1280 + 64 * (j))
#define XB_XGEN(j)  (2304 + 64 * (j))
#define XB_TOP      3328
#define XB_TOPGEN   3392
#define XCD_BAR_WORDS 3456
#define XB_SPIN_CAP (1u << 20)
__device__ __forceinline__ unsigned xb_ld(unsigned* p)              { return __hip_atomic_load(p, __ATOMIC_RELAXED, __HIP_MEMORY_SCOPE_AGENT); }
__device__ __forceinline__ unsigned xb_add(unsigned* p, unsigned v) { return __hip_atomic_fetch_add(p, v, __ATOMIC_RELAXED, __HIP_MEMORY_SCOPE_AGENT); }
__device__ __forceinline__ unsigned xb_xcc_id() { return (unsigned)__builtin_amdgcn_s_getreg((3 << 11) | 20) & 0xFu; }
#define XB_SPIN(cond, bar) do { unsigned _sp = 0; while (cond) { __builtin_amdgcn_s_sleep(1); \
    if ((++_sp & 255u) == 0u) { if (xb_ld(&(bar)[XB_TMO])) break; if (_sp > XB_SPIN_CAP) { atomicAdd(&(bar)[XB_TMO], 1u); break; } } } } while (0)
struct XcdBarrier { unsigned* bar; unsigned x; volatile LAS unsigned* st; };
__device__ __forceinline__ XcdBarrier xcd_barrier_post(unsigned* bar, volatile LAS unsigned* st) {
    XcdBarrier b; b.bar = bar; b.x = xb_xcc_id(); b.st = st;
    if (threadIdx.x == 0) (void)xb_add(&bar[XB_XCNT(b.x)], 1u);
    return b;
}
__device__ __forceinline__ void xcd_barrier_complete(unsigned* bar, unsigned x, unsigned& nloc, unsigned& nx) {
    const unsigned G = gridDim.x * gridDim.y * gridDim.z;
    unsigned sum, cnt, mine, sp = 0u;
    for (;;) {
        sum = 0u; cnt = 0u; mine = 0u;
#pragma unroll
        for (unsigned j = 0; j < 16; ++j) { const unsigned c = xb_ld(&bar[XB_XCNT(j)]); sum += c; cnt += (c > 0u) ? 1u : 0u; mine = (j == x) ? c : mine; }
        if (sum == G) break;
        __builtin_amdgcn_s_sleep(1);
        if ((++sp & 255u) == 0u) { if (xb_ld(&bar[XB_TMO])) break; if (sp > XB_SPIN_CAP) { atomicAdd(&bar[XB_TMO], 1u); break; } }
    }
    nloc = mine > 0u ? mine : 1u; nx = cnt > 0u ? cnt : 1u;
}
__device__ __forceinline__ void xcd_barrier(const XcdBarrier& b) {
    asm volatile("s_waitcnt vmcnt(0)" ::: "memory");
    __syncthreads();
    if (threadIdx.x == 0) {
        unsigned* bar = b.bar;
        __builtin_amdgcn_s_waitcnt(0);
        unsigned nloc = b.st[0], nx = b.st[1];
        if (nloc == 0u) { xcd_barrier_complete(bar, b.x, nloc, nx); b.st[0] = nloc; b.st[1] = nx; }
        const unsigned old = xb_add(&bar[XB_XSUB(b.x)], 1u);
        const unsigned gen = old / nloc;
        if (old + 1u == (gen + 1u) * nloc) {
            __builtin_amdgcn_fence(__ATOMIC_RELEASE, "agent");
            asm volatile("s_waitcnt vmcnt(0)" ::: "memory");
            const unsigned og = xb_add(&bar[XB_TOP], 1u);
            const unsigned tg = og / nx;
            if (og + 1u == (tg + 1u) * nx) xb_add(&bar[XB_TOPGEN], 1u);
            else XB_SPIN(xb_ld(&bar[XB_TOPGEN]) == tg, bar);
            __builtin_amdgcn_fence(__ATOMIC_ACQUIRE, "agent");
            xb_add(&bar[XB_XGEN(b.x)], 1u);
            asm volatile("s_waitcnt vmcnt(0)" ::: "memory");
        } else {
            XB_SPIN(xb_ld(&bar[XB_XGEN(b.x)]) == gen, bar);
            __builtin_amdgcn_fence(__ATOMIC_ACQUIRE, "agent");
            asm volatile("s_waitcnt vmcnt(0)" ::: "memory");
        }
    }
    __syncthreads();
}

__global__ void __launch_bounds__(NT, 2) mega(Args a) {
    extern __shared__ __attribute__((aligned(16))) unsigned char lds[];
    cg::grid_group grid = cg::this_grid();
    PG8_LAS unsigned char* glds = (PG8_LAS unsigned char*)lds;
    float* fl = (float*)lds;
    unsigned char* ws = a.ws;
    float* modv = (float*)(ws + WS_MOD);
    float* xc = (float*)(ws + WS_XC);
    bf16_t* H = (bf16_t*)(ws + WS_H); bf16_t* P = (bf16_t*)(ws + WS_P); bf16_t* HFF = (bf16_t*)(ws + WS_P);
    bf16_t* AST = (bf16_t*)(ws + WS_AST);
    bf16_t* BR0 = (bf16_t*)(ws + WS_BR0); bf16_t* BR1 = (bf16_t*)(ws + WS_BR1); bf16_t* MRG = (bf16_t*)(ws + WS_MRG);
    bf16_t* OBH = (bf16_t*)(ws + WS_O);
    const int G = gridDim.x, bx = obid();
    volatile LAS unsigned* bst = (volatile LAS unsigned*)((LAS unsigned char*)lds + (LDS_BYTES - 16));
    if (threadIdx.x == 0) { bst[0] = 0u; bst[1] = 0u; }
    __syncthreads();
    (void)xcd_barrier_post((unsigned*)(ws + WS_BAR), bst);
#define GSYNC() do { XcdBarrier xb_; xb_.bar = (unsigned*)(a.ws + WS_BAR); xb_.x = xb_xcc_id(); xb_.st = (volatile LAS unsigned*)((LAS unsigned char*)lds + (LDS_BYTES - 16)); xcd_barrier(xb_); } while (0)

    mod_phase(a, fl, modv, 0, 128, G);
    __syncthreads();
    wconv_phase(a, 0, fl, 1, 0);
    if (a.ws == nullptr) grid.sync();
    GSYNC();
    if (PROBE_DUP == 9) { for (int i = 0; i < 20; ++i) GSYNC(); }
    { RowPass rp{}; rp.src_lat = a.in[0]; rp.src_ctx = a.in[2]; rp.dst_lat = nullptr; rp.dst_ctx = nullptr; rp.o = nullptr;
      rp.h = H; rp.gpre = a.in[6]; rp.shv = modv + 0 * 2048; rp.scv = modv + 1 * 2048; rp.nrows = MROWS; row_pass(rp); }
    GSYNC();

    for (int l = 0; l < 2; ++l) {
        const bool last = (l == 1);
        const int mact = last ? MLAT : MROWS;
        const float* modl = modv + (size_t)l * 3 * 12288;
        { pg8::Gemm g{H, (const bf16_t*)(ws + WS_WIN), MROWS, NINP, D}; pg8::StaticOrder S; S.init(MROWS, NINP, G, bx);
          EpiStore16 E{P, NINP}; pg8::gemm_phase<EpiStore16, pg8::StaticOrder, true, true>(glds, g, S, E); }
        GSYNC();
        prep_phase(a, l, fl);
        la_phase(a, l);
        if (PROBE_DUP == 4) prep_phase(a, l, fl);
        GSYNC();
        prep2_phase(a, fl);
        GSYNC();
        ssd_state_phase(a, fl);
        __syncthreads();
        attn_phase(a, l, !last, lds);
        if (!last) { const int nfill = (G >= 128) ? G - 64 : G; __syncthreads(); wconv_phase(a, 0, fl, 2 | 4 | 8 | 16, 0, nfill); __syncthreads(); mod_phase(a, fl, modv, 128, 256, nfill); }
        if (PROBE_DUP == 1) { __syncthreads(); attn_phase(a, l, !last, lds); }
        if (PROBE_DUP == 2) { __syncthreads(); ssd_state_phase(a, fl); }
        GSYNC();
        s5_phase(a, l, lds);
        __syncthreads();
        ssd_out_phase(a, lds, last ? 1 : 0);
        if (PROBE_DUP == 2) { __syncthreads(); ssd_out_phase(a, lds, last ? 1 : 0); }
        if (PROBE_DUP == 3) { __syncthreads(); s5_phase(a, l, lds); }
        GSYNC();
        post_phase(a, l, mact);
        if (PROBE_DUP == 4) post_phase(a, l, mact);
        GSYNC();
        { pg8::Gemm g{AST, (const bf16_t*)(ws + WS_WSTK), mact, 2048, 1024}; pg8::MultiOrder S; S.init(mact, 2048, 3, MT, G, bx);
          EpiG1 E{AST + (size_t)3 * MROWS * 1024, a.in[28] + l * 2048, BR0, BR1, P}; pg8::gemm_phase<EpiG1, pg8::MultiOrder, true, true>(glds, g, S, E); }
        GSYNC();
        { pg8::Gemm g{AST + (size_t)3 * MROWS * 1024, (const bf16_t*)(ws + WS_WSTK) + (size_t)3 * 2048 * 1024, mact, 2048, 1024}; pg8::StaticOrder S; S.init(mact, 2048, G, bx);
          EpiG2 E{MRG, BR0, BR1, P}; pg8::gemm_phase<EpiG2, pg8::StaticOrder, true, true>(glds, g, S, E); }
        if (!last) { __syncthreads(); wconv_phase(a, 1, fl, 32, 16); }
        GSYNC();
        { pg8::Gemm g{MRG, (const bf16_t*)(ws + WS_WOUT), mact, 2048, 2048}; pg8::StaticOrder S; S.init(mact, 2048, G, bx);
          EpiStore16 E{OBH, D}; pg8::gemm_phase<EpiStore16, pg8::StaticOrder, true, true>(glds, g, S, E); }
        if (!last) { __syncthreads(); wconv_phase(a, 1, fl, 64, 16); }
        GSYNC();
        { RowPass rp{}; rp.src_lat = (l == 0) ? a.in[0] : a.out; rp.src_ctx = (l == 0) ? a.in[2] : xc; rp.dst_lat = a.out; rp.dst_ctx = xc; rp.o = OBH; rp.gpost = a.in[7] + l * D; rp.gatev = modl + 2 * 2048;
          rp.h = H; rp.gpre = a.in[8] + l * D; rp.shv = modl + 3 * 2048; rp.scv = modl + 4 * 2048; rp.nrows = mact; row_pass(rp); }
        GSYNC();
        { pg8::Gemm g{H, (const bf16_t*)(ws + WS_WGU), mact, 2 * DFF, D}; pg8::StaticOrder S; S.init(mact, 2 * DFF, G, bx);
          EpiPair<0> E{HFF, DFF, nullptr}; pg8::gemm_phase<EpiPair<0>, pg8::StaticOrder, true, true>(glds, g, S, E); }
        GSYNC();
        { pg8::Gemm g{HFF, (const bf16_t*)(ws + WS_WDN), mact, 2048, DFF}; pg8::StaticOrder S; S.init(mact, 2048, G, bx);
          EpiStore16 E{OBH, D}; pg8::gemm_phase<EpiStore16, pg8::StaticOrder, true, true>(glds, g, S, E); }
        if (!last) { __syncthreads(); wconv_phase(a, 1, fl, 2 | 4 | 8, 16); }
        GSYNC();
        { RowPass rp{}; rp.src_lat = a.out; rp.src_ctx = xc; rp.dst_lat = a.out; rp.dst_ctx = xc; rp.o = OBH; rp.gpost = a.in[9] + l * D; rp.gatev = modl + 5 * 2048;
          if (!last) { rp.h = H; rp.gpre = a.in[6] + D; rp.shv = modv + (size_t)3 * 12288 + 0 * 2048; rp.scv = modv + (size_t)3 * 12288 + 1 * 2048; }
          rp.nrows = mact; row_pass(rp); }
        if (!last) { __syncthreads(); wconv_phase(a, 1, fl, 16, 0); GSYNC(); }
    }
}

extern "C" void kernel_launch(void* const* d_in, const int* in_sizes, int n_in, void* d_out, int out_size, void* d_ws, size_t ws_size, hipStream_t stream) {
    static int grid_blocks = 0;
    if (!grid_blocks) {
        int dev = 0, cus = 0, per_cu = 0;
        (void)hipGetDevice(&dev);
        (void)hipDeviceGetAttribute(&cus, hipDeviceAttributeMultiprocessorCount, dev);
        (void)hipFuncSetAttribute((const void*)mega, hipFuncAttributeMaxDynamicSharedMemorySize, LDS_BYTES);
        (void)hipOccupancyMaxActiveBlocksPerMultiprocessor(&per_cu, (const void*)mega, NT, LDS_BYTES);
        if (per_cu < 1) per_cu = 1;
        if (per_cu > 1) per_cu = 1;
        grid_blocks = cus * per_cu;
        if (ws_size < WS_END) fprintf(stderr, "kernel_launch: workspace too small: %zu < %zu\n", ws_size, (size_t)WS_END);
    }
    (void)hipMemsetAsync((unsigned char*)d_ws + WS_BAR, 0, WS_BAR_BYTES, stream);
    Args a{};
    for (int i = 0; i < 34; ++i) a.in[i] = (const float*)d_in[i];
    a.out = (float*)d_out; a.ws = (unsigned char*)d_ws;
    void* args[] = {&a};
    hipError_t e = hipLaunchCooperativeKernel((void*)mega, dim3(grid_blocks), dim3(NT), args, LDS_BYTES, stream);
    if (e != hipSuccess) fprintf(stderr, "cooperative launch failed: %s (grid %d)\n", hipGetErrorString(e), grid_blocks);
}
```
